# Optimizing an MI355X kernel written in HIP

```python
import jax, jax.numpy as jnp
from jax import lax
import numpy as np

D_MODEL = 2048
BATCH = 16
SEQ = 2048
DEPTH = 2

GRID_W = 64
CTX_LEN = 256
N_MOD = 9
FFN_DIM = 5632
HEAD_DIM = 128
HALF_ROT = HEAD_DIM // 2
ATTN_HEADS = 8
ATTN_KV_HEADS = 2
ATTN_GROUP = ATTN_HEADS // ATTN_KV_HEADS
ATTN_WIDTH = ATTN_HEADS * HEAD_DIM
KV_WIDTH = ATTN_KV_HEADS * HEAD_DIM
RET_HEADS = 4
RET_DK = 128
RET_DV = 128
RET_WIDTH = RET_HEADS * RET_DK
FOURIER_GROUPS = 4
FOURIER_GROUP_DIM = 128
FOURIER_WIDTH = FOURIER_GROUPS * FOURIER_GROUP_DIM
IN_WIDTH = ATTN_WIDTH + 2 * KV_WIDTH + 4 * RET_WIDTH + FOURIER_WIDTH
IN_SPLITS = (
    ATTN_WIDTH,
    ATTN_WIDTH + KV_WIDTH,
    ATTN_WIDTH + 2 * KV_WIDTH,
    ATTN_WIDTH + 2 * KV_WIDTH + RET_WIDTH,
    ATTN_WIDTH + 2 * KV_WIDTH + 2 * RET_WIDTH,
    ATTN_WIDTH + 2 * KV_WIDTH + 3 * RET_WIDTH,
    ATTN_WIDTH + 2 * KV_WIDTH + 4 * RET_WIDTH,
)
Q_BLOCK = 128
RET_CHUNK = 128
ROPE_THETA = 10000.0
RET_DECAY_BASE = 5
EPS = 1e-6

kernel_name = "hybrid_fourier_gqa_retention_macaron_dit"


def rmsnorm(x, gain=None):
    xf = x.astype(jnp.float32)
    y = xf * lax.rsqrt(jnp.mean(xf * xf, axis=-1, keepdims=True) + EPS)
    if gain is not None:
        y = y * gain.astype(jnp.float32)
    return y.astype(x.dtype)


def modulate(x, shift, scale):
    return x * (1 + scale) + shift


def adaln(c_act, w_ada, b_ada):
    m = (c_act @ w_ada + b_ada).reshape(c_act.shape[0], N_MOD, D_MODEL)
    return [m[:, i, None, :] for i in range(N_MOD)]


def swiglu(x, w_gate, w_up, w_down):
    return (jax.nn.silu(x @ w_gate) * (x @ w_up)) @ w_down


def axial_rope_angles(rows):
    n = rows * GRID_W
    t = jnp.arange(n)
    row = jnp.repeat(jnp.arange(rows), GRID_W).astype(jnp.float32)
    col = (t % GRID_W).astype(jnp.float32)
    inv = ROPE_THETA ** (-jnp.arange(0, HALF_ROT, 2, dtype=jnp.float32) / HALF_ROT)
    return row[:, None] * inv[None], col[:, None] * inv[None]


def _rotate(xh, ang):
    half = xh.shape[-1] // 2
    x1, x2 = xh[..., :half], xh[..., half:]
    cos = jnp.cos(ang)[None, :, None, :].astype(xh.dtype)
    sin = jnp.sin(ang)[None, :, None, :].astype(xh.dtype)
    return jnp.concatenate([x1 * cos - x2 * sin, x1 * sin + x2 * cos], axis=-1)


def apply_axial_rope(x, ang_row, ang_col):
    return jnp.concatenate([_rotate(x[..., :HALF_ROT], ang_row),
                            _rotate(x[..., HALF_ROT:], ang_col)], axis=-1)


def gqa_attend(q, k, v):
    B, L, H, hd = q.shape
    nblk = L // Q_BLOCK
    qb = q.reshape(B, nblk, Q_BLOCK, ATTN_KV_HEADS, ATTN_GROUP, hd).transpose(1, 0, 2, 3, 4, 5)
    scale = hd ** -0.5

    def block(qi):
        s = jnp.einsum('bqkgd,bskd->bkgqs', qi, k, preferred_element_type=jnp.float32) * scale
        p = jax.nn.softmax(s, axis=-1).astype(v.dtype)
        return jnp.einsum('bkgqs,bskd->bqkgd', p, v)

    o = lax.map(block, qb)
    return o.transpose(1, 0, 2, 3, 4, 5).reshape(B, L, H * hd)


def retention_chunkwise(q, k, v, log_gamma, state0):
    B, H, L, dk = q.shape
    dv = v.shape[-1]
    C = RET_CHUNK
    n = L // C
    idx = jnp.arange(C, dtype=jnp.float32)
    lg = log_gamma[:, None]
    rel = idx[:, None] - idx[None, :]
    decay_in = jnp.where(rel[None] >= 0, jnp.exp(lg[:, :, None] * jnp.maximum(rel, 0.0)[None]), 0.0)
    decay_q = jnp.exp(lg * (idx + 1.0))[None, :, :, None]
    decay_k = jnp.exp(lg * (C - 1.0 - idx))[None, :, :, None]
    decay_c = jnp.exp(log_gamma * C)[None, :, None, None]
    qs = jnp.moveaxis(q.reshape(B, H, n, C, dk), 2, 0)
    ks = jnp.moveaxis(k.reshape(B, H, n, C, dk), 2, 0)
    vs = jnp.moveaxis(v.reshape(B, H, n, C, dv), 2, 0)

    def step(state, qkv):
        qc, kc, vc = qkv
        inner = jnp.einsum('bhid,bhjd->bhij', qc, kc) * decay_in
        o = jnp.einsum('bhij,bhje->bhie', inner, vc) + jnp.einsum('bhid,bhde->bhie', qc, state) * decay_q
        state = state * decay_c + jnp.einsum('bhjd,bhje->bhde', kc * decay_k, vc)
        return state, o

    state, o = lax.scan(step, state0, (qs, ks, vs))
    return jnp.moveaxis(o, 0, 2).reshape(B, H, L, dv), state


def retention_final_state(k, v, log_gamma):
    L = k.shape[2]
    w = jnp.exp(log_gamma[:, None] * (L - 1.0 - jnp.arange(L, dtype=jnp.float32))[None])
    return jnp.einsum('bhsd,bhse,hs->bhde', k, v, w)


def _ret_heads(t):
    B, L, _ = t.shape
    return t.reshape(B, L, RET_HEADS, -1).transpose(0, 2, 1, 3).astype(jnp.float32)


def _ret_output(o, zg):
    B, H, L, dv = o.shape
    o = o * lax.rsqrt(jnp.mean(o * o, axis=-1, keepdims=True) + EPS)
    o = o.transpose(0, 2, 1, 3).reshape(B, L, H * dv).astype(zg.dtype)
    return jax.nn.silu(zg) * o


def retention_mixer(rq, rk, rv, rg, rqc, rkc, rvc, rgc, ret_decay, need_ctx):
    log_g = -jnp.exp(ret_decay.astype(jnp.float32))
    q, k, v = _ret_heads(rq), _ret_heads(rk) * RET_DK ** -0.5, _ret_heads(rv)
    qc, kc, vc = _ret_heads(rqc), _ret_heads(rkc) * RET_DK ** -0.5, _ret_heads(rvc)
    flip = lambda t: t[:, :, ::-1]
    if need_ctx:
        zeros = jnp.zeros((kc.shape[0], RET_HEADS, RET_DK, RET_DV), jnp.float32)
        oc_f, s_f = retention_chunkwise(qc, kc, vc, log_g[0], zeros)
        oc_b, s_b = retention_chunkwise(flip(qc), flip(kc), flip(vc), log_g[1], zeros)
        y_ctx = _ret_output(oc_f + flip(oc_b), rgc)
    else:
        s_f = retention_final_state(kc, vc, log_g[0])
        s_b = retention_final_state(flip(kc), flip(vc), log_g[1])
        y_ctx = None
    o_f, _ = retention_chunkwise(q, k, v, log_g[0], s_f)
    o_b, _ = retention_chunkwise(flip(q), flip(k), flip(v), log_g[1], s_b)
    return _ret_output(o_f + flip(o_b), rg), y_ctx


def fourier_mix(z):
    B, L, _ = z.shape
    zf = z.reshape(B, L, FOURIER_GROUPS, FOURIER_GROUP_DIM).astype(jnp.float32)
    y = jnp.fft.fftn(zf, axes=(1, 3), norm='ortho').real
    return y.reshape(B, L, FOURIER_WIDTH).astype(z.dtype)


def merge_branches(u, y_f, y_a, y_r, w_bf, w_ba, w_br, w_mg, b_mg, w_out):
    g_f, g_a, g_r = jnp.split(jax.nn.sigmoid(u @ w_mg + b_mg), 3, axis=-1)
    m = g_f * (y_f @ w_bf) + g_a * (y_a @ w_ba) + g_r * (y_r @ w_br)
    return m @ w_out


def token_mixer(u, uc, ang_row, ang_col, w_in, q_norm, k_norm, ret_decay,
                w_bf, w_ba, w_br, w_mg, b_mg, w_out, need_ctx):
    B, L, _ = u.shape
    Lc = uc.shape[1]
    aq, ak, av, rq, rk, rv, rg, fz = jnp.split(u @ w_in, IN_SPLITS, axis=-1)
    aqc, akc, avc, rqc, rkc, rvc, rgc, fzc = jnp.split(uc @ w_in, IN_SPLITS, axis=-1)
    q = apply_axial_rope(rmsnorm(aq.reshape(B, L, ATTN_HEADS, HEAD_DIM), q_norm), ang_row, ang_col)
    k = apply_axial_rope(rmsnorm(ak.reshape(B, L, ATTN_KV_HEADS, HEAD_DIM), k_norm), ang_row, ang_col)
    v = av.reshape(B, L, ATTN_KV_HEADS, HEAD_DIM)
    kc = rmsnorm(akc.reshape(B, Lc, ATTN_KV_HEADS, HEAD_DIM), k_norm)
    vc = avc.reshape(B, Lc, ATTN_KV_HEADS, HEAD_DIM)
    y_attn = gqa_attend(q, jnp.concatenate([kc, k], axis=1), jnp.concatenate([vc, v], axis=1))
    y_ret, y_ret_c = retention_mixer(rq, rk, rv, rg, rqc, rkc, rvc, rgc, ret_decay, need_ctx)
    y_four = fourier_mix(fz)
    out = merge_branches(u, y_four, y_attn, y_ret, w_bf, w_ba, w_br, w_mg, b_mg, w_out)
    if need_ctx:
        qc = rmsnorm(aqc.reshape(B, Lc, ATTN_HEADS, HEAD_DIM), q_norm)
        y_attn_c = gqa_attend(qc, kc, vc)
        out_c = merge_branches(uc, fourier_mix(fzc), y_attn_c, y_ret_c,
                               w_bf, w_ba, w_br, w_mg, b_mg, w_out)
    else:
        out_c = None
    return out, out_c


def setup_inputs(seed: int = 0) -> dict:
    key = jax.random.key(seed)
    ks = jax.random.split(key, 32)
    f32 = jnp.float32
    nrm = lambda k, shape, s: jax.random.normal(k, shape, f32) * s
    gain = lambda k, shape: 1.0 + 0.02 * jax.random.normal(k, shape, f32)
    L = DEPTH
    gam = 1.0 - 2.0 ** (-(RET_DECAY_BASE + jnp.arange(RET_HEADS, dtype=f32)))
    decay_base = jnp.log(-jnp.log(gam))
    return {
        'x': nrm(ks[0], (BATCH, SEQ, D_MODEL), 1.0),
        'c': nrm(ks[1], (BATCH, D_MODEL), 1.0),
        'ctx': nrm(ks[2], (BATCH, CTX_LEN, D_MODEL), 1.0),
        'c_ctx': nrm(ks[3], (D_MODEL,), 1.0),
        'w_ada': nrm(ks[4], (L, D_MODEL, N_MOD * D_MODEL), 0.5 * D_MODEL ** -0.5),
        'b_ada': nrm(ks[5], (L, N_MOD * D_MODEL), 0.01),
        'ffn1_norm': gain(ks[6], (L, D_MODEL)),
        'ffn1_w_gate': nrm(ks[7], (L, D_MODEL, FFN_DIM), D_MODEL ** -0.5),
        'ffn1_w_up': nrm(ks[8], (L, D_MODEL, FFN_DIM), D_MODEL ** -0.5),
        'ffn1_w_down': nrm(ks[9], (L, FFN_DIM, D_MODEL), FFN_DIM ** -0.5),
        'mix_norm': gain(ks[10], (L, D_MODEL)),
        'w_in': nrm(ks[11], (L, D_MODEL, IN_WIDTH), D_MODEL ** -0.5),
        'q_norm': gain(ks[12], (L, HEAD_DIM)),
        'k_norm': gain(ks[13], (L, HEAD_DIM)),
        'ret_decay': decay_base[None, None, :] + nrm(ks[14], (L, 2, RET_HEADS), 0.01),
        'w_branch_fourier': nrm(ks[15], (L, FOURIER_WIDTH, D_MODEL), FOURIER_WIDTH ** -0.5),
        'w_branch_attn': nrm(ks[16], (L, ATTN_WIDTH, D_MODEL), ATTN_WIDTH ** -0.5),
        'w_branch_ret': nrm(ks[17], (L, RET_WIDTH, D_MODEL), RET_WIDTH ** -0.5),
        'w_merge_gate': nrm(ks[18], (L, D_MODEL, 3 * D_MODEL), D_MODEL ** -0.5),
        'b_merge_gate': nrm(ks[19], (L, 3 * D_MODEL), 0.01),
        'w_out': nrm(ks[20], (L, D_MODEL, D_MODEL), D_MODEL ** -0.5),
        'ffn2_norm': gain(ks[21], (L, D_MODEL)),
        'ffn2_w_gate': nrm(ks[22], (L, D_MODEL, FFN_DIM), D_MODEL ** -0.5),
        'ffn2_w_up': nrm(ks[23], (L, D_MODEL, FFN_DIM), D_MODEL ** -0.5),
        'ffn2_w_down': nrm(ks[24], (L, FFN_DIM, D_MODEL), FFN_DIM ** -0.5),
        'final_norm': gain(ks[25], (D_MODEL,)),
    }


def reference(x, c, ctx, c_ctx, w_ada, b_ada, ffn1_norm, ffn1_w_gate, ffn1_w_up, ffn1_w_down,
              mix_norm, w_in, q_norm, k_norm, ret_decay, w_branch_fourier, w_branch_attn,
              w_branch_ret, w_merge_gate, b_merge_gate, w_out, ffn2_norm, ffn2_w_gate,
              ffn2_w_up, ffn2_w_down, final_norm):
    n_lat = x.shape[1]
    rows = n_lat // GRID_W
    ang_row, ang_col = axial_rope_angles(rows)
    c_act = jax.nn.silu(c)
    cc_act = jax.nn.silu(c_ctx)[None]
    h, hc = x, ctx
    for l in range(DEPTH):
        need_ctx = l < DEPTH - 1
        m = adaln(c_act, w_ada[l], b_ada[l])
        mc = adaln(cc_act, w_ada[l], b_ada[l])
        h = h + 0.5 * m[2] * swiglu(modulate(rmsnorm(h, ffn1_norm[l]), m[0], m[1]),
                                    ffn1_w_gate[l], ffn1_w_up[l], ffn1_w_down[l])
        hc = hc + 0.5 * mc[2] * swiglu(modulate(rmsnorm(hc, ffn1_norm[l]), mc[0], mc[1]),
                                       ffn1_w_gate[l], ffn1_w_up[l], ffn1_w_down[l])
        u = modulate(rmsnorm(h, mix_norm[l]), m[3], m[4])
        uc = modulate(rmsnorm(hc, mix_norm[l]), mc[3], mc[4])
        out, out_c = token_mixer(u, uc, ang_row, ang_col, w_in[l], q_norm[l], k_norm[l], ret_decay[l],
                                 w_branch_fourier[l], w_branch_attn[l], w_branch_ret[l],
                                 w_merge_gate[l], b_merge_gate[l], w_out[l], need_ctx)
        h = h + m[5] * out
        h = h + 0.5 * m[8] * swiglu(modulate(rmsnorm(h, ffn2_norm[l]), m[6], m[7]),
                                    ffn2_w_gate[l], ffn2_w_up[l], ffn2_w_down[l])
        if need_ctx:
            hc = hc + mc[5] * out_c
            hc = hc + 0.5 * mc[8] * swiglu(modulate(rmsnorm(hc, ffn2_norm[l]), mc[6], mc[7]),
                                           ffn2_w_gate[l], ffn2_w_up[l], ffn2_w_down[l])
    return rmsnorm(h, final_norm)
```

```cpp
#include <hip/hip_runtime.h>
#include <hip/hip_bf16.h>
#include <cstdio>
#include <cstdint>
#ifndef MK_PER_PHASE
#define MK_PER_PHASE 0
#endif
namespace pg8 {
#define PG8_LAS __attribute__((address_space(3)))
typedef unsigned short bf16_t;
typedef short bf16x8 __attribute__((ext_vector_type(8)));
typedef float f32x4 __attribute__((ext_vector_type(4)));
typedef unsigned u32x4 __attribute__((ext_vector_type(4)));
constexpr int BM = 256, BK = 64, HALF = 128, HTB = HALF * BK * 2  , STAGE_BYTES = 8 * HTB, NXCD = 8, WGM = 8;

__host__ __device__ __forceinline__ int lds_byte(int r, int c) { const int st = (r >> 4) * 2 + (c >> 5), rr = r & 15, cc = c & 31, ob = rr * 64 + cc * 2; return st * 1024 + (ob ^ (((ob >> 9) & 1) << 5)); }
__host__ __device__ __forceinline__ void stage_rc(int b, int& R, int& C) { const int st = b / 1024, sb = b % 1024, swz = sb ^ (((sb >> 9) & 1) << 5); R = (st >> 1) * 16 + swz / 64; C = (st & 1) * 32 + (swz % 64) / 2; }
__host__ __device__ __forceinline__ int perm32(int rho) { const int n = rho >> 4, i = rho & 15; return 8 * (i >> 2) + 4 * n + (i & 3); }

struct Unit { int pm, pn; };
struct Gemm { const bf16_t* A; const bf16_t* Bt; int M, N, K; int lda = 0, ldb = 0; };
__device__ __forceinline__ unsigned cvt_pk_bf16(float lo, float hi) { unsigned r; asm volatile("v_cvt_pk_bf16_f32 %0, %1, %2" : "=v"(r) : "v"(lo), "v"(hi)); return r; }
typedef float f32x2 __attribute__((ext_vector_type(2)));
struct Order2 {
    int nM1, nN1, nM2, nN2, pm2, split, a0, a1, n1, total, G, c;
    __device__ __forceinline__ void init(int nM1_, int nN1_, int nM2_, int nN2_, int pm2_, int split_, int a0_, int a1_, int G_, int c_) {
        nM1 = nM1_; nN1 = nN1_; nM2 = nM2_; nN2 = nN2_; pm2 = pm2_; split = split_; a0 = a0_; a1 = a1_; n1 = nM1 * nN1; total = n1 + nM2 * nN2; G = G_; c = c_; }
    __device__ __forceinline__ void rect(int nM, int nN, int G_, int c_) { init(nM, nN, 0, 1, 0, 0, 0, 0, G_, c_); }
    __device__ __forceinline__ bool next(int i, Unit& u) const {
        const long L = (long)i * G + c; if (L >= total) return false;
        if (nM1 == 144 && nN1 == 8 && nM2 == 0 && G == 256) {
            const int xcd = c & 7, o = c >> 3;
            const int grp = (i < 4) ? xcd * 4 + i : 32 + (xcd >> 1), idx = (i < 4) ? o : (xcd & 1) * 16 + o;
            u.pm = grp * 4 + (idx & 3); u.pn = idx >> 2; return true; }
        int w = (int)L; { const int q = total / NXCD, r = total % NXCD, xcd = w % NXCD, off = w / NXCD; w = (xcd < r ? xcd * (q + 1) : r * (q + 1) + (xcd - r) * q) + off; }
        int nM = nM1, nN = nN1; const bool second = w >= n1; if (second) { w -= n1; nM = nM2; nN = nN2; }
        const int wgm = 4;
        const int nig = wgm * nN, gid = w / nig, fm = gid * wgm, gsz = (nM - fm) < wgm ? (nM - fm) : wgm;
        int pm = fm + ((w % nig) % gsz), pn = (w % nig) / gsz;
        if (second) { pm += pm2; pn = pn < split ? a0 + pn : a1 + pn; }
        u.pm = pm; u.pn = pn; return true;
    }
    __device__ __forceinline__ void a_ready(const Unit&) const {}
    __device__ __forceinline__ void done(const Unit&) const {}
};

__device__ __forceinline__ float fast_sigmoid(float x) { return __builtin_amdgcn_rcpf(1.0f + __builtin_amdgcn_exp2f(-1.4426950408889634f * x)); }
__device__ __forceinline__ u32x4 pack8(const f32x4 v0, const f32x4 v1) { u32x4 w; w.x = cvt_pk_bf16(v0[0], v0[1]); w.y = cvt_pk_bf16(v0[2], v0[3]); w.z = cvt_pk_bf16(v1[0], v1[1]); w.w = cvt_pk_bf16(v1[2], v1[3]); return w; }
__device__ __forceinline__ void unpack8(const u32x4 w, f32x4& v0, f32x4& v1) {
    v0[0] = __uint_as_float(w.x << 16); v0[1] = __uint_as_float(w.x & 0xffff0000u); v0[2] = __uint_as_float(w.y << 16); v0[3] = __uint_as_float(w.y & 0xffff0000u);
    v1[0] = __uint_as_float(w.z << 16); v1[1] = __uint_as_float(w.z & 0xffff0000u); v1[2] = __uint_as_float(w.w << 16); v1[3] = __uint_as_float(w.w & 0xffff0000u); }

typedef _Float16 f16x2 __attribute__((ext_vector_type(2)));
__device__ __forceinline__ unsigned pk_h2(float lo, float hi) { const f16x2 h = {(_Float16)lo, (_Float16)hi}; return __builtin_bit_cast(unsigned, h); }
__device__ __forceinline__ u32x4 pack8h(const f32x4 v0, const f32x4 v1) { u32x4 w; w.x = pk_h2(v0[0], v0[1]); w.y = pk_h2(v0[2], v0[3]); w.z = pk_h2(v1[0], v1[1]); w.w = pk_h2(v1[2], v1[3]); return w; }
typedef _Float16 f16x8 __attribute__((ext_vector_type(8)));
typedef float f32x8 __attribute__((ext_vector_type(8)));
__device__ __forceinline__ void unpack8h(const u32x4 w, f32x4& v0, f32x4& v1) {
    const f32x8 f = __builtin_convertvector(__builtin_bit_cast(f16x8, w), f32x8);
    v0 = (f32x4){f[0], f[1], f[2], f[3]}; v1 = (f32x4){f[4], f[5], f[6], f[7]}; }
constexpr int NLAT_TILES = 128, DM = 2048, NMODC = 18432;

struct EpiSwiglu {
    static constexpr bool PERM = true, AFTER_DRAIN = false;
    bf16_t* H; int ldh; bool dry = false;
    __device__ __forceinline__ void operator()(const f32x4 (&acc)[2][2][4][2], const Unit& u, int wr, int wc, int fr_, int fq) const {
        int fr = fr_; asm volatile("" : "+v"(fr));
#ifdef PROBE_DRYFAST
        if (dry) { float t = 0.f;
#pragma unroll
            for (int ai = 0; ai < 2; ++ai)
#pragma unroll
                for (int bj = 0; bj < 2; ++bj)
#pragma unroll
                    for (int m = 0; m < 4; ++m)
#pragma unroll
                        for (int n = 0; n < 2; ++n) t += (acc[ai][bj][m][n][0] + acc[ai][bj][m][n][1]) + (acc[ai][bj][m][n][2] + acc[ai][bj][m][n][3]);
            if (t == 12345.678f) H[fr] = 0; return; }
#endif
        bf16_t* Hblk = H + ((size_t)(u.pm * (ldh / BK) + 2 * u.pn + (wc >> 1)) * BM + wr * 64 + fr) * BK + (wc & 1) * 32 + 8 * fq;
#pragma unroll
        for (int ai = 0; ai < 2; ++ai)
#pragma unroll
            for (int m = 0; m < 4; ++m) {
                f32x4 v0, v1;
#pragma unroll
                for (int j = 0; j < 4; ++j) { const float g0 = acc[ai][0][m][0][j], g1 = acc[ai][0][m][1][j];
                    v0[j] = g0 * fast_sigmoid(g0) * acc[ai][1][m][0][j]; v1[j] = g1 * fast_sigmoid(g1) * acc[ai][1][m][1][j]; }
                *(u32x4*)(Hblk + (size_t)(ai * HALF + m * 16) * BK) = pack8(v0, v1); }
    }
};
template <bool BASE_F32> struct EpiResidB {
    static constexpr bool PERM = true, AFTER_DRAIN = false;
    const void* base_lat; const void* base_ctx; bf16_t* out_lat; bf16_t* out_ctx; const float* mod; int gi; float s;
    __device__ __forceinline__ void operator()(const f32x4 (&acc)[2][2][4][2], const Unit& u, int wr, int wc, int fr_, int fq_) const {
        int fr = fr_, fq = fq_; asm volatile("" : "+v"(fr), "+v"(fq));
        const bool lat = u.pm < NLAT_TILES; const int rb = lat ? (u.pm >> 3) : 16; const size_t t0 = (size_t)(lat ? u.pm : u.pm - NLAT_TILES) * BM * DM;
        const int col0 = u.pn * BM + wc * 32 + 8 * fq; const float* gp = mod + (size_t)rb * NMODC + gi * DM + col0;
        f32x4 gv[2][2];
#pragma unroll
        for (int bj = 0; bj < 2; ++bj)
#pragma unroll
            for (int n = 0; n < 2; ++n) gv[bj][n] = *(const f32x4*)(gp + bj * HALF + 4 * n) * s;
        const size_t roff = t0 + (size_t)(wr * 64 + fr) * DM + col0;
        bf16_t* out = (lat ? out_lat : out_ctx) + roff;
        if (BASE_F32) {
            const float* base = (const float*)(lat ? base_lat : base_ctx) + roff;
#pragma unroll
            for (int ai = 0; ai < 2; ++ai) {
                f32x4 bs[4][2][2];
#pragma unroll
                for (int m = 0; m < 4; ++m)
#pragma unroll
                    for (int bj = 0; bj < 2; ++bj)
#pragma unroll
                        for (int n = 0; n < 2; ++n) bs[m][bj][n] = *(const f32x4*)(base + (size_t)(ai * HALF + m * 16) * DM + bj * HALF + 4 * n);
#pragma unroll
                for (int m = 0; m < 4; ++m)
#pragma unroll
                    for (int bj = 0; bj < 2; ++bj) *(u32x4*)(out + (size_t)(ai * HALF + m * 16) * DM + bj * HALF) = pack8h(bs[m][bj][0] + gv[bj][0] * acc[ai][bj][m][0], bs[m][bj][1] + gv[bj][1] * acc[ai][bj][m][1]);
                asm volatile("" ::: "memory"); }
        } else {
            const bf16_t* base = (const bf16_t*)(lat ? base_lat : base_ctx) + roff;
#pragma unroll
            for (int ai = 0; ai < 2; ++ai) {
                u32x4 bw[4][2];
#pragma unroll
                for (int m = 0; m < 4; ++m)
#pragma unroll
                    for (int bj = 0; bj < 2; ++bj) bw[m][bj] = *(const u32x4*)(base + (size_t)(ai * HALF + m * 16) * DM + bj * HALF);
#pragma unroll
                for (int m = 0; m < 4; ++m)
#pragma unroll
                    for (int bj = 0; bj < 2; ++bj) { f32x4 b0, b1; unpack8h(bw[m][bj], b0, b1);
                        *(u32x4*)(out + (size_t)(ai * HALF + m * 16) * DM + bj * HALF) = pack8h(b0 + gv[bj][0] * acc[ai][bj][m][0], b1 + gv[bj][1] * acc[ai][bj][m][1]); }
                asm volatile("" ::: "memory"); }
        }
    }
};
template <bool BASE_F32, bool FINAL> struct EpiResidNorm {
    static constexpr bool PERM = true, AFTER_DRAIN = false;
    const void* base_lat; const void* base_ctx; bf16_t* out_lat; bf16_t* out_ctx; const float* mod; int gi; float s;
    const float* gain; const float* nmod; int ish, isc; bf16_t* XN; float* OUTF; float* xbuf; unsigned* cnt; PG8_LAS unsigned char* xl;
    __device__ __forceinline__ void operator()(f32x4 (&acc)[2][2][4][2], const Unit& u, int wr, int wc, int fr_, int fq_) const {
        int fr = fr_, fq = fq_; asm volatile("" : "+v"(fr), "+v"(fq));
        const bool lat = u.pm < NLAT_TILES; const int rb = lat ? (u.pm >> 3) : 16; const size_t t0 = (size_t)(lat ? u.pm : u.pm - NLAT_TILES) * BM * DM;
        const int col0 = u.pn * BM + wc * 32 + 8 * fq; const float* gp = mod + (size_t)rb * NMODC + gi * DM + col0;
        f32x4 gv[2][2];
#pragma unroll
        for (int bj = 0; bj < 2; ++bj)
#pragma unroll
            for (int n = 0; n < 2; ++n) gv[bj][n] = *(const f32x4*)(gp + bj * HALF + 4 * n) * s;
        const size_t roff = t0 + (size_t)(wr * 64 + fr) * DM + col0;
        if (BASE_F32) { const float* base = (const float*)(lat ? base_lat : base_ctx) + roff;
#pragma unroll
            for (int ai = 0; ai < 2; ++ai)
#pragma unroll
                for (int mh = 0; mh < 2; ++mh) { f32x4 bs[2][2][2];
#pragma unroll
                    for (int m = 0; m < 2; ++m)
#pragma unroll
                        for (int bj = 0; bj < 2; ++bj)
#pragma unroll
                            for (int n = 0; n < 2; ++n) bs[m][bj][n] = *(const f32x4*)(base + (size_t)(ai * HALF + (2 * mh + m) * 16) * DM + bj * HALF + 4 * n);
#pragma unroll
                    for (int m = 0; m < 2; ++m)
#pragma unroll
                        for (int bj = 0; bj < 2; ++bj)
#pragma unroll
                            for (int n = 0; n < 2; ++n) acc[ai][bj][2 * mh + m][n] = bs[m][bj][n] + gv[bj][n] * acc[ai][bj][2 * mh + m][n];
                    asm volatile("" : "+v"(acc[ai][0][2 * mh][0]), "+v"(acc[ai][0][2 * mh][1]), "+v"(acc[ai][1][2 * mh][0]), "+v"(acc[ai][1][2 * mh][1]),
                                      "+v"(acc[ai][0][2 * mh + 1][0]), "+v"(acc[ai][0][2 * mh + 1][1]), "+v"(acc[ai][1][2 * mh + 1][0]), "+v"(acc[ai][1][2 * mh + 1][1]) :: "memory"); }
        } else { const bf16_t* base = (const bf16_t*)(lat ? base_lat : base_ctx) + roff;
#pragma unroll
            for (int ai = 0; ai < 2; ++ai) { u32x4 bw[4][2];
#pragma unroll
                for (int m = 0; m < 4; ++m)
#pragma unroll
                    for (int bj = 0; bj < 2; ++bj) bw[m][bj] = *(const u32x4*)(base + (size_t)(ai * HALF + m * 16) * DM + bj * HALF);
#pragma unroll
                for (int m = 0; m < 4; ++m)
#pragma unroll
                    for (int bj = 0; bj < 2; ++bj) { f32x4 b0, b1; unpack8h(bw[m][bj], b0, b1); acc[ai][bj][m][0] = b0 + gv[bj][0] * acc[ai][bj][m][0]; acc[ai][bj][m][1] = b1 + gv[bj][1] * acc[ai][bj][m][1]; }
                asm volatile("" : "+v"(acc[ai][0][0][0]), "+v"(acc[ai][0][0][1]), "+v"(acc[ai][1][0][0]), "+v"(acc[ai][1][0][1]), "+v"(acc[ai][0][1][0]), "+v"(acc[ai][0][1][1]), "+v"(acc[ai][1][1][0]), "+v"(acc[ai][1][1][1]),
                                  "+v"(acc[ai][0][2][0]), "+v"(acc[ai][0][2][1]), "+v"(acc[ai][1][2][0]), "+v"(acc[ai][1][2][1]), "+v"(acc[ai][0][3][0]), "+v"(acc[ai][0][3][1]), "+v"(acc[ai][1][3][0]), "+v"(acc[ai][1][3][1]) :: "memory"); }
        }
        PG8_LAS float* P = (PG8_LAS float*)xl; PG8_LAS float* S = P + 1024;
#pragma unroll
        for (int ai = 0; ai < 2; ++ai)
#pragma unroll
            for (int m = 0; m < 4; ++m) { float q = 0.f;
#pragma unroll
                for (int bj = 0; bj < 2; ++bj)
#pragma unroll
                    for (int n = 0; n < 2; ++n) { const f32x4 x = acc[ai][bj][m][n]; q += (x[0] * x[0] + x[1] * x[1]) + (x[2] * x[2] + x[3] * x[3]); }
                { auto s_ = __builtin_amdgcn_permlane16_swap(__float_as_uint(q), __float_as_uint(q), false, false); q = __uint_as_float(s_[0]) + __uint_as_float(s_[1]); }
                { auto s_ = __builtin_amdgcn_permlane32_swap(__float_as_uint(q), __float_as_uint(q), false, false); q = __uint_as_float(s_[0]) + __uint_as_float(s_[1]); }
                if (fq == 0) P[(ai * HALF + wr * 64 + m * 16 + fr) * 4 + wc] = q; }
        asm volatile("s_waitcnt lgkmcnt(0)" ::: "memory"); __builtin_amdgcn_s_barrier(); asm volatile("" ::: "memory");
        const int wid = wr * 4 + wc, lane = fq * 16 + fr, row = wid * 32 + (lane & 31);
        if (lane < 32) { const float t = (P[row * 4 + 0] + P[row * 4 + 1]) + (P[row * 4 + 2] + P[row * 4 + 3]);
            __hip_atomic_store(xbuf + ((size_t)u.pm * BM + row) * 8 + u.pn, t, __ATOMIC_RELAXED, __HIP_MEMORY_SCOPE_AGENT); }
        asm volatile("s_waitcnt vmcnt(0)" ::: "memory");
        if (lane == 0) __hip_atomic_fetch_add(cnt + 16 * u.pm, 1u, __ATOMIC_RELAXED, __HIP_MEMORY_SCOPE_AGENT);
        if (!FINAL) { bf16_t* out = (lat ? out_lat : out_ctx) + roff;
#pragma unroll
            for (int ai = 0; ai < 2; ++ai)
#pragma unroll
                for (int m = 0; m < 4; ++m)
#pragma unroll
                    for (int bj = 0; bj < 2; ++bj) *(u32x4*)(out + (size_t)(ai * HALF + m * 16) * DM + bj * HALF) = pack8h(acc[ai][bj][m][0], acc[ai][bj][m][1]); }
        f32x4 av[2][2], sv[2][2];
#pragma unroll
        for (int bj = 0; bj < 2; ++bj)
#pragma unroll
            for (int n = 0; n < 2; ++n) { const int col = col0 + bj * HALF + 4 * n; const f32x4 g = *(const f32x4*)(gain + col);
                if (FINAL) { av[bj][n] = g; sv[bj][n] = (f32x4){0.f, 0.f, 0.f, 0.f}; }
                else { const float* mp = nmod + (size_t)rb * NMODC; av[bj][n] = g * (*(const f32x4*)(mp + isc * DM + col) + 1.0f); sv[bj][n] = *(const f32x4*)(mp + ish * DM + col); } }
        if (wid == 0) { if (lane == 0) { unsigned sp = 0u; while (__hip_atomic_load(cnt + 16 * u.pm, __ATOMIC_RELAXED, __HIP_MEMORY_SCOPE_AGENT) < 64u) { __builtin_amdgcn_s_sleep(1); if (++sp > (1u << 17)) break; } } }
        asm volatile("s_waitcnt lgkmcnt(0)" ::: "memory"); __builtin_amdgcn_s_barrier(); asm volatile("" ::: "memory");
        if (lane < 32) { const float* slot = xbuf + ((size_t)u.pm * BM + row) * 8; float t8[8];
#pragma unroll
            for (int t = 0; t < 8; ++t) t8[t] = __hip_atomic_load(slot + t, __ATOMIC_RELAXED, __HIP_MEMORY_SCOPE_AGENT);
            const float tot = ((t8[0] + t8[1]) + (t8[2] + t8[3])) + ((t8[4] + t8[5]) + (t8[6] + t8[7]));
            S[row] = __builtin_amdgcn_rsqf(tot * (1.0f / DM) + 1e-6f); }
        asm volatile("s_waitcnt lgkmcnt(0)" ::: "memory"); __builtin_amdgcn_s_barrier(); asm volatile("" ::: "memory");
#pragma unroll
        for (int ai = 0; ai < 2; ++ai)
#pragma unroll
            for (int m = 0; m < 4; ++m) { const int r = ai * HALF + wr * 64 + m * 16 + fr; const float rs = S[r];
#pragma unroll
                for (int bj = 0; bj < 2; ++bj) { const f32x4 y0 = acc[ai][bj][m][0] * rs * av[bj][0] + sv[bj][0], y1 = acc[ai][bj][m][1] * rs * av[bj][1] + sv[bj][1];
                    if (FINAL) { float* o = OUTF + ((size_t)u.pm * BM + r) * DM + col0 + bj * HALF; *(f32x4*)o = y0; *(f32x4*)(o + 4) = y1; }
                    else *(u32x4*)(XN + (((size_t)u.pm * (DM / BK) + u.pn * 4 + bj * 2 + (wc >> 1)) * BM + r) * BK + (wc & 1) * 32 + 8 * fq) = pack8(y0, y1); } }
    }
};
struct EpiMix {
    static constexpr bool PERM = true, AFTER_DRAIN = false;
    bf16_t *Q, *K, *V, *R, *G; const float* bmg;
    __device__ __forceinline__ void operator()(const f32x4 (&acc)[2][2][4][2], const Unit& u, int wr, int wc, int fr_, int fq) const {
        int fr = fr_; asm volatile("" : "+v"(fr));
        const int pn = u.pn; bf16_t* O; int ld, colt; size_t rowt = (size_t)u.pm * BM; const bool gate = pn >= 14;
        if (pn < 4) { O = Q; ld = 1024; colt = pn * BM; }
        else if (pn < 6) { O = (pn == 4) ? K : V; ld = 256; colt = 0; rowt = (u.pm < NLAT_TILES) ? (size_t)(u.pm >> 3) * 2304 + 256 + (size_t)(u.pm & 7) * BM : (size_t)(u.pm - NLAT_TILES) * 2304; }
        else if (pn < 14) { O = R; ld = 2048; colt = (pn - 6) * BM; }
        else { O = G; ld = 6144; colt = (pn - 14) * BM; }
        const int cl = wc * 32 + 8 * fq;
        f32x4 bv[2][2];
#pragma unroll
        for (int bj = 0; bj < 2; ++bj)
#pragma unroll
            for (int n = 0; n < 2; ++n) bv[bj][n] = *(const f32x4*)(bmg + (gate ? colt : 0) + cl + bj * HALF + 4 * n) * (gate ? 1.0f : 0.0f);
        bf16_t* ob = O + (rowt + wr * 64 + fr) * ld + colt + cl;
#pragma unroll
        for (int ai = 0; ai < 2; ++ai)
#pragma unroll
            for (int m = 0; m < 4; ++m)
#pragma unroll
                for (int bj = 0; bj < 2; ++bj) { f32x4 v0 = acc[ai][bj][m][0], v1 = acc[ai][bj][m][1];
                    v0 += bv[bj][0]; v1 += bv[bj][1];
                    if (gate) {
#pragma unroll
                        for (int j = 0; j < 4; ++j) { v0[j] = fast_sigmoid(v0[j]); v1[j] = fast_sigmoid(v1[j]); } }
                    *(u32x4*)(ob + (size_t)(ai * HALF + m * 16) * ld + bj * HALF) = pack8(v0, v1); }
    }
};
template <int MODE> struct EpiPlain {
    static constexpr bool PERM = true, AFTER_DRAIN = false;
    bf16_t* O0; bf16_t* O1; float scale; int L;
    __device__ __forceinline__ void operator()(const f32x4 (&acc)[2][2][4][2], const Unit& u, int wr, int wc, int fr_, int fq) const {
        int fr = fr_; asm volatile("" : "+v"(fr));
        bf16_t* O; int ld, colt;
        if (MODE == 0) { if (u.pn < NLAT_TILES) { O = O0 + (size_t)(u.pn >> 3) * 1024 * 2048; ld = 2048; colt = (u.pn & 7) * BM; } else { O = O1 + (size_t)(u.pn - NLAT_TILES) * 1024 * 256; ld = 256; colt = 0; } }
        else { O = O0 + (size_t)(u.pn >> 1) * L * 512; ld = 512; colt = (u.pn & 1) * BM; }
        bf16_t* ob = O + (size_t)(u.pm * BM + wr * 64 + fr) * ld + colt + wc * 32 + 8 * fq;
#pragma unroll
        for (int ai = 0; ai < 2; ++ai)
#pragma unroll
            for (int m = 0; m < 4; ++m)
#pragma unroll
                for (int bj = 0; bj < 2; ++bj) *(u32x4*)(ob + (size_t)(ai * HALF + m * 16) * ld + bj * HALF) = pack8(acc[ai][bj][m][0] * scale, acc[ai][bj][m][1] * scale);
    }
};
struct EpiFold {
    static constexpr bool PERM = true, AFTER_DRAIN = false;
    bf16_t* O0; bf16_t* O1;
    __device__ __forceinline__ void operator()(const f32x4 (&acc)[2][2][4][2], const Unit& u, int wr, int wc, int fr_, int fq) const {
        int fr = fr_; asm volatile("" : "+v"(fr));
        const bool lat = u.pn < NLAT_TILES;
        const int b = lat ? (u.pn >> 3) : (u.pn - NLAT_TILES), ld = lat ? 2048 : 256, col0 = (lat ? (u.pn & 7) * BM : 0) + wc * 32 + 8 * fq;
        bf16_t* base = lat ? O0 : O1; const size_t tsz = (size_t)16 * 256 * ld;
        bf16_t* ob = base + (size_t)wr * tsz + (size_t)(b * 256 + u.pm * 128 + fr) * ld + col0;
        bf16_t* on = base + 2 * tsz + (size_t)(b * 4 + u.pm * 2) * ld + col0;
#pragma unroll
        for (int ai = 0; ai < 2; ++ai)
#pragma unroll
            for (int m = 0; m < 4; ++m)
#pragma unroll
                for (int bj = 0; bj < 2; ++bj) { const u32x4 w = pack8(acc[ai][bj][m][0], acc[ai][bj][m][1]);
                    *(u32x4*)(ob + (size_t)(ai * 64 + m * 16) * ld + bj * HALF) = w;
                    if (m == 0) { if (wr == 1 && fr == 0) *(u32x4*)(on + (size_t)ai * ld + bj * HALF) = w; } }
    }
};
struct EpiDft {
    static constexpr bool PERM = true, AFTER_DRAIN = false;
    bf16_t* O0; float scale; int L; int type;
    __device__ __forceinline__ void operator()(const f32x4 (&acc)[2][2][4][2], const Unit& u, int wr, int wc, int fr_, int fq) const {
        int fr = fr_; asm volatile("" : "+v"(fr));
        bf16_t* ob = O0 + ((size_t)u.pn * L + u.pm * BM + wr * 64 + fr) * 512 + (wc >> 1) * 128 + type * 64 + (wc & 1) * 32 + 8 * fq;
#pragma unroll
        for (int ai = 0; ai < 2; ++ai)
#pragma unroll
            for (int m = 0; m < 4; ++m)
#pragma unroll
                for (int bj = 0; bj < 2; ++bj) *(u32x4*)(ob + (size_t)(ai * HALF + m * 16) * 512 + bj * 256) = pack8(acc[ai][bj][m][0] * scale, acc[ai][bj][m][1] * scale);
    }
};
struct EpiNyq {
    static constexpr bool PERM = true, AFTER_DRAIN = false;
    bf16_t* O0; float scale; int L;
    __device__ __forceinline__ void operator()(const f32x4 (&acc)[2][2][4][2], const Unit& u, int wr, int wc, int fr_, int fq) const {
        int fr = fr_; asm volatile("" : "+v"(fr));
        if (wc < 2) { const int c0 = wc * 32 + 8 * fq, b0 = c0 >> 2;
            bf16_t* ob = O0 + ((size_t)b0 * L + u.pm * BM + wr * 64 + fr) * 512 + 64;
#pragma unroll
            for (int ai = 0; ai < 2; ++ai)
#pragma unroll
                for (int m = 0; m < 4; ++m) { const u32x4 w = pack8(acc[ai][0][m][0] * scale, acc[ai][0][m][1] * scale); bf16_t* o = ob + (size_t)(ai * HALF + m * 16) * 512;
                    o[0] = (bf16_t)(w.x & 0xffffu); o[128] = (bf16_t)(w.x >> 16); o[256] = (bf16_t)(w.y & 0xffffu); o[384] = (bf16_t)(w.y >> 16);
                    bf16_t* o2 = o + (size_t)L * 512;
                    o2[0] = (bf16_t)(w.z & 0xffffu); o2[128] = (bf16_t)(w.z >> 16); o2[256] = (bf16_t)(w.w & 0xffffu); o2[384] = (bf16_t)(w.w >> 16); } }
    }
};
struct EpiNyqP {
    static constexpr bool PERM = true, AFTER_DRAIN = false;
    float* Pp;
    __device__ __forceinline__ void operator()(const f32x4 (&acc)[2][2][4][2], const Unit& u, int wr, int wc, int fr_, int fq) const {
        int fr = fr_; asm volatile("" : "+v"(fr));
        if (wc < 2) { float* ob = Pp + (size_t)(u.pm * BM + wr * 64 + fr) * 64 + wc * 32 + 8 * fq;
#pragma unroll
            for (int ai = 0; ai < 2; ++ai)
#pragma unroll
                for (int m = 0; m < 4; ++m) { float* o = ob + (size_t)(ai * HALF + m * 16) * 64; *(f32x4*)o = acc[ai][0][m][0]; *(f32x4*)(o + 4) = acc[ai][0][m][1]; } }
    }
};
template <bool FIRST> struct EpiMerge {
    static constexpr bool PERM = true, AFTER_DRAIN = false;
    bf16_t* Mo; const bf16_t* G; int goff; bf16_t* Mdst = nullptr;
    __device__ __forceinline__ void operator()(const f32x4 (&acc)[2][2][4][2], const Unit& u, int wr, int wc, int fr_, int fq) const {
        int fr = fr_; asm volatile("" : "+v"(fr));
        const size_t row0 = (size_t)u.pm * BM + wr * 64 + fr; const int col0 = u.pn * BM + wc * 32 + 8 * fq;
#pragma unroll
        for (int ai = 0; ai < 2; ++ai) {
            u32x4 gw[4][2], ow[4][2];
#pragma unroll
            for (int m = 0; m < 4; ++m)
#pragma unroll
                for (int bj = 0; bj < 2; ++bj) { const size_t r = row0 + ai * HALF + m * 16; const int c = col0 + bj * HALF;
                    gw[m][bj] = *(const u32x4*)(G + r * 6144 + goff + c); if (!FIRST) ow[m][bj] = *(const u32x4*)(Mo + r * DM + c); }
#pragma unroll
            for (int m = 0; m < 4; ++m)
#pragma unroll
                for (int bj = 0; bj < 2; ++bj) { const size_t r = row0 + ai * HALF + m * 16; const int c = col0 + bj * HALF;
                    f32x4 g0, g1; unpack8(gw[m][bj], g0, g1);
                    f32x4 v0 = g0 * acc[ai][bj][m][0], v1 = g1 * acc[ai][bj][m][1];
                    if (!FIRST) { f32x4 o0, o1; unpack8(ow[m][bj], o0, o1); v0 += o0; v1 += o1; }
                    *(u32x4*)((Mdst ? Mdst : Mo) + r * DM + c) = pack8(v0, v1); }
            asm volatile("" ::: "memory"); }
    }
};
template <class Epi, class Sched, bool ALIGN_EPI = false, bool SP2 = false, bool ABLK = false, bool BBLK = false>
__device__ __forceinline__ void gemm_phase(PG8_LAS unsigned char* lds, const Gemm g, const Sched& S, const Epi& E) {
    int tid_ = threadIdx.x; asm volatile("" : "+v"(tid_));
    const int tid = tid_, wid = __builtin_amdgcn_readfirstlane(tid >> 6), lane = tid & 63, wr = wid >> 2, wc = wid & 3, fr = lane & 15, fq = lane >> 4;
    const int K = g.K, nt = K / BK, LDA = g.lda ? g.lda : K, LDB = g.ldb ? g.ldb : K;
    unsigned voffA[2], voffB[2];
#pragma unroll
    for (int i = 0; i < 2; ++i) { int R, C; stage_rc(tid * 16 + i * 8192, R, C); const int Rb = Epi::PERM ? ((R & ~31) + perm32(R & 31)) : R;
        voffA[i] = ABLK ? (unsigned)(R * BK + C) * 2u : (unsigned)(R * LDA + C) * 2u; voffB[i] = BBLK ? (unsigned)(Rb * BK + C) * 2u : (unsigned)(Rb * LDB + C) * 2u; }
    const size_t kstep = (size_t)(BK * 2);
    const size_t hstepa = (size_t)HALF * LDA * 2, hstepb = (size_t)HALF * LDB * 2;
    const size_t kstepA = ABLK ? (size_t)BM * BK * 2 : kstep, hstepA = ABLK ? (size_t)HALF * BK * 2 : hstepa, tstepA = ABLK ? (size_t)nt * BM * BK * 2 : 2 * hstepa;
    const size_t kstepB = BBLK ? (size_t)BM * BK * 2 : kstep, hstepB = BBLK ? (size_t)HALF * BK * 2 : hstepb, tstepB = BBLK ? (size_t)nt * BM * BK * 2 : 2 * hstepb;
    const unsigned ldsw = (unsigned)wid * 1024u;
    const int aoff = lds_byte(wr * 64 + fr, fq * 8), boff = lds_byte(wc * 32 + fr, fq * 8);
#define PG8_SA(b, h) (((b) * 2 + (h)) * HTB)
#define PG8_SB(b, h) ((4 + (b) * 2 + (h)) * HTB)
#define PG8_STAGE(bufoff, gbase, voff) do { _Pragma("unroll") for (int _i = 0; _i < 2; ++_i) \
        __builtin_amdgcn_global_load_lds((const unsigned*)((const char*)(gbase) + (voff)[_i]), (PG8_LAS unsigned*)(lds + (bufoff) + ldsw + _i * 8192), 16, 0, 0); } while (0)
#define PG8_LDA(dst, b, h) do { _Pragma("unroll") for (int m = 0; m < 4; ++m) _Pragma("unroll") for (int k = 0; k < 2; ++k) dst[m][k] = *(const PG8_LAS bf16x8*)(lds + PG8_SA(b, h) + aoff + m * 2048 + k * 1024); } while (0)
#define PG8_LDB(dst, b, h) do { _Pragma("unroll") for (int n = 0; n < 2; ++n) _Pragma("unroll") for (int k = 0; k < 2; ++k) dst[n][k] = *(const PG8_LAS bf16x8*)(lds + PG8_SB(b, h) + boff + n * 2048 + k * 1024); } while (0)
#define PG8_MMA(ai, bj, At, Bt) do { __builtin_amdgcn_s_setprio(1); _Pragma("unroll") for (int m = 0; m < 4; ++m) _Pragma("unroll") for (int n = 0; n < 2; ++n) _Pragma("unroll") for (int k = 0; k < 2; ++k) \
        acc[ai][bj][m][n] = __builtin_amdgcn_mfma_f32_16x16x32_bf16(Bt[n][k], At[m][k], acc[ai][bj][m][n], 0, 0, 0); __builtin_amdgcn_s_setprio(0); } while (0)
#define PG8_WAIT_V(n) asm volatile("s_waitcnt vmcnt(" #n ")" ::: "memory")
#define PG8_WAIT_L(n) asm volatile("s_waitcnt lgkmcnt(" #n ")" ::: "memory")
#define PG8_BAR __builtin_amdgcn_s_barrier()
#define PG8_SCHED __builtin_amdgcn_sched_barrier(0)
    Unit cur, nxt; int ui = 0;
    if (!S.next(0, cur)) return;
    f32x4 acc[2][2][4][2];
#pragma unroll
    for (int a = 0; a < 2; ++a)
#pragma unroll
        for (int b = 0; b < 2; ++b)
#pragma unroll
            for (int m = 0; m < 4; ++m)
#pragma unroll
                for (int n = 0; n < 2; ++n) acc[a][b][m][n] = (f32x4){0.f, 0.f, 0.f, 0.f};
    bf16x8 At[4][2], B0[2][2], B1[2][2];
    const char* cA = (const char*)g.A + (size_t)cur.pm * tstepA; const char* cB = (const char*)g.Bt + (size_t)cur.pn * tstepB;
    S.a_ready(cur);
    if constexpr (SP2) {
        PG8_STAGE(PG8_SB(0, 0), cB, voffB); PG8_STAGE(PG8_SB(0, 1), cB + hstepB, voffB); PG8_STAGE(PG8_SA(0, 0), cA, voffA); PG8_STAGE(PG8_SA(0, 1), cA + hstepA, voffA);
        if (wr == 1) PG8_BAR;
        PG8_WAIT_V(2); PG8_BAR;
        PG8_STAGE(PG8_SB(1, 0), cB + kstepB, voffB); PG8_STAGE(PG8_SA(1, 0), cA + kstepA, voffA); PG8_STAGE(PG8_SB(1, 1), cB + hstepB + kstepB, voffB);
        PG8_WAIT_V(6); PG8_BAR;
    } else {
        PG8_STAGE(PG8_SB(0, 0), cB, voffB); PG8_STAGE(PG8_SA(0, 0), cA, voffA); PG8_STAGE(PG8_SB(0, 1), cB + hstepB, voffB); PG8_STAGE(PG8_SA(0, 1), cA + hstepA, voffA);
        if (wr == 1) PG8_BAR;
        PG8_WAIT_V(4); PG8_BAR;
        PG8_STAGE(PG8_SB(1, 0), cB + kstepB, voffB); PG8_STAGE(PG8_SA(1, 0), cA + kstepA, voffA); PG8_STAGE(PG8_SB(1, 1), cB + hstepB + kstepB, voffB);
        PG8_WAIT_V(6); PG8_BAR;
    }
    for (;;) {
        const bool has_next = S.next(ui + 1, nxt);
        const char* nA = has_next ? (const char*)g.A + (size_t)nxt.pm * tstepA : cA; const char* nB = has_next ? (const char*)g.Bt + (size_t)nxt.pn * tstepB : cB;
        for (int t = 0; t < nt; t += 2) {
            const bool last = (t == nt - 2);
            const char* a1 = cA + (size_t)(t + 1) * kstepA;
            const char* a2 = last ? nA : cA + (size_t)(t + 2) * kstepA; const char* b2 = last ? nB : cB + (size_t)(t + 2) * kstepB;
            const char* a3 = a2 + kstepA; const char* b3 = b2 + kstepB;
            if (last && has_next) S.a_ready(nxt);
            if constexpr (SP2) {
            PG8_LDB(B0, 0, 0); PG8_LDB(B1, 0, 1); PG8_SCHED; PG8_LDA(At, 0, 0); PG8_STAGE(PG8_SA(1, 1), a1 + hstepA, voffA);
            PG8_WAIT_V(8); PG8_WAIT_L(0); PG8_BAR; PG8_MMA(0, 0, At, B0); PG8_MMA(0, 1, At, B1); PG8_BAR; PG8_SCHED;
            PG8_LDA(At, 0, 1); PG8_STAGE(PG8_SB(0, 0), b2, voffB); PG8_STAGE(PG8_SB(0, 1), b2 + hstepB, voffB); PG8_STAGE(PG8_SA(0, 0), a2, voffA);
            PG8_WAIT_V(8); PG8_WAIT_L(0); PG8_BAR; PG8_MMA(1, 0, At, B0); PG8_MMA(1, 1, At, B1); PG8_BAR; PG8_SCHED;
            PG8_LDB(B0, 1, 0); PG8_LDB(B1, 1, 1); PG8_SCHED; PG8_LDA(At, 1, 0); PG8_STAGE(PG8_SA(0, 1), a2 + hstepA, voffA);
            PG8_WAIT_V(8); PG8_WAIT_L(0); PG8_BAR; PG8_MMA(0, 0, At, B0); PG8_MMA(0, 1, At, B1); PG8_BAR; PG8_SCHED;
            PG8_LDA(At, 1, 1); PG8_STAGE(PG8_SB(1, 0), b3, voffB); PG8_STAGE(PG8_SB(1, 1), b3 + hstepB, voffB); PG8_STAGE(PG8_SA(1, 0), a3, voffA);
            PG8_WAIT_V(8); PG8_WAIT_L(0); PG8_BAR; PG8_MMA(1, 0, At, B0); PG8_MMA(1, 1, At, B1); PG8_BAR; PG8_SCHED;
            } else {
            PG8_LDB(B0, 0, 0); PG8_SCHED; PG8_LDA(At, 0, 0); PG8_STAGE(PG8_SA(1, 1), a1 + hstepA, voffA);
            PG8_WAIT_L(8); PG8_BAR; PG8_WAIT_L(0); PG8_MMA(0, 0, At, B0); PG8_BAR; PG8_SCHED;
            PG8_LDB(B1, 0, 1); PG8_STAGE(PG8_SB(0, 0), b2, voffB);
            PG8_BAR; PG8_WAIT_L(0); PG8_MMA(0, 1, At, B1); PG8_BAR;
            PG8_LDA(At, 0, 1); PG8_STAGE(PG8_SA(0, 0), a2, voffA);
            PG8_BAR; PG8_WAIT_L(0); PG8_MMA(1, 0, At, B0); PG8_BAR; PG8_SCHED;
            PG8_STAGE(PG8_SB(0, 1), b2 + hstepB, voffB);
            PG8_WAIT_V(6); PG8_BAR; PG8_MMA(1, 1, At, B1); PG8_BAR;
            PG8_LDB(B0, 1, 0); PG8_SCHED; PG8_LDA(At, 1, 0); PG8_STAGE(PG8_SA(0, 1), a2 + hstepA, voffA);
            PG8_WAIT_L(8); PG8_BAR; PG8_WAIT_L(0); PG8_MMA(0, 0, At, B0); PG8_BAR; PG8_SCHED;
            PG8_LDB(B1, 1, 1); PG8_STAGE(PG8_SB(1, 0), b3, voffB);
            PG8_BAR; PG8_WAIT_L(0); PG8_MMA(0, 1, At, B1); PG8_BAR;
            PG8_LDA(At, 1, 1); PG8_STAGE(PG8_SA(1, 0), a3, voffA);
            PG8_BAR; PG8_WAIT_L(0); PG8_MMA(1, 0, At, B0); PG8_BAR; PG8_SCHED;
            PG8_STAGE(PG8_SB(1, 1), b3 + hstepB, voffB);
            PG8_WAIT_V(6); PG8_BAR; PG8_MMA(1, 1, At, B1); PG8_BAR;
            }
        }
        if constexpr (ALIGN_EPI) { if (wr == 0) PG8_BAR; }
        if constexpr (!Epi::AFTER_DRAIN) { E(acc, cur, wr, wc, fr, fq); S.done(cur); }
        if (!has_next) break;
#pragma unroll
        for (int a = 0; a < 2; ++a)
#pragma unroll
            for (int b = 0; b < 2; ++b)
#pragma unroll
                for (int m = 0; m < 4; ++m)
#pragma unroll
                    for (int n = 0; n < 2; ++n) acc[a][b][m][n] = (f32x4){0.f, 0.f, 0.f, 0.f};
        cur = nxt; cA = nA; cB = nB; ++ui;
        if constexpr (ALIGN_EPI) { if (wr == 1) PG8_BAR; }
    }
    PG8_WAIT_V(0);
    if constexpr (!ALIGN_EPI) { if (wr == 0) PG8_BAR; }
    PG8_BAR;
    if constexpr (Epi::AFTER_DRAIN) { E.fused(acc, cur, wr, wc, fr, fq, lds, wid, lane); S.done(cur); }
#undef PG8_SA
#undef PG8_SB
#undef PG8_STAGE
#undef PG8_LDA
#undef PG8_LDB
#undef PG8_MMA
#undef PG8_WAIT_V
#undef PG8_WAIT_L
#undef PG8_BAR
#undef PG8_SCHED
}
}
namespace att {
using bf16 = unsigned short;
using bf16x8 = __attribute__((ext_vector_type(8))) short;
using s16x4  = __attribute__((ext_vector_type(4))) short;
using f32x16 = __attribute__((ext_vector_type(16))) float;
using f32x4  = __attribute__((ext_vector_type(4))) float;
using u32x4  = __attribute__((ext_vector_type(4))) unsigned;
using u32x2  = __attribute__((ext_vector_type(2))) unsigned;
constexpr int   D = 128, NW = 8, QBLK = 32, KVBLK = 64;
constexpr float SCALE = 0.088388347648318440f;
constexpr float THR = 8.f;
constexpr int SDEPTH = 2;
constexpr size_t SHM_V = KVBLK * D * 2, SHM_K = KVBLK * D * 2, SHM_ATTN = 2 * SHM_V + 2 * SHM_K + NW * 64 * 4;
#define KSWZ(row, colB) ((row) * 256 + ((colB) ^ (((row) & 7) << 4)))
#define SBAR() __builtin_amdgcn_sched_barrier(0)
__device__ __forceinline__ int crow(int r, int hi) { return (r & 3) + 8 * (r >> 2) + 4 * hi; }
__device__ __forceinline__ unsigned cvtpk(float lo, float hi) { unsigned r; asm volatile("v_cvt_pk_bf16_f32 %0, %1, %2" : "=v"(r) : "v"(lo), "v"(hi)); return r; }
__device__ __forceinline__ bf16x8 ld8(const bf16* p) { return *reinterpret_cast<const bf16x8*>(p); }
__device__ __forceinline__ float bf2f(unsigned short b) { return __uint_as_float(((unsigned)b) << 16); }
__device__ __forceinline__ unsigned short f2bf(float f) { return (unsigned short)(cvtpk(f, 0.f) & 0xffffu); }

__device__ __forceinline__ void partialSM(f32x16& p0, f32x16& p1, float& m_reg, float& mn, float& alpha) {
  constexpr float C = SCALE * 1.4426950408889634f;
  float pmax = p0[0]; for (int r = 1; r < 16; ++r) pmax = fmaxf(pmax, p0[r]); for (int r = 0; r < 16; ++r) pmax = fmaxf(pmax, p1[r]);
  { auto rr = __builtin_amdgcn_permlane32_swap(__float_as_uint(pmax), __float_as_uint(pmax), false, false);
    pmax = fmaxf(__uint_as_float(rr[0]), __uint_as_float(rr[1])); }
  if (__builtin_expect(__all(pmax - m_reg <= THR / SCALE), 1)) { mn = m_reg; alpha = 1.f; }
  else { mn = fmaxf(m_reg, pmax); alpha = __builtin_amdgcn_exp2f((m_reg - mn) * C); m_reg = mn; }
  float mnC = -mn * C;
  for (int r = 0; r < 16; ++r) p0[r] = fmaf(p0[r], C, mnC); for (int r = 0; r < 16; ++r) p1[r] = fmaf(p1[r], C, mnC);
  for (int r = 0; r < 16; ++r) p0[r] = __builtin_amdgcn_exp2f(p0[r]);
}
#define PK4(P, BASE, OUT) do { unsigned a0 = cvtpk(P[BASE + 0], P[BASE + 1]), a1 = cvtpk(P[BASE + 2], P[BASE + 3]);   \
    unsigned b0 = cvtpk(P[BASE + 4], P[BASE + 5]), b1 = cvtpk(P[BASE + 6], P[BASE + 7]);                              \
    auto r0 = __builtin_amdgcn_permlane32_swap(a0, b0, false, false); auto r1 = __builtin_amdgcn_permlane32_swap(a1, b1, false, false); \
    u32x4 w = {r0[0], r1[0], r0[1], r1[1]}; OUT = *reinterpret_cast<bf16x8*>(&w); } while (0)
__device__ __forceinline__ void finishSM(f32x16& p0, f32x16& p1, float alpha, float& l_reg, bf16x8& pa0, bf16x8& pa1, bf16x8& pa2, bf16x8& pa3) {
  for (int r = 0; r < 16; ++r) p1[r] = __builtin_amdgcn_exp2f(p1[r]);
  float ps = 0; for (int r = 0; r < 16; ++r) ps += p0[r]; for (int r = 0; r < 16; ++r) ps += p1[r];
  { auto rr = __builtin_amdgcn_permlane32_swap(__float_as_uint(ps), __float_as_uint(ps), false, false);
    ps = __uint_as_float(rr[0]) + __uint_as_float(rr[1]); }
  l_reg = l_reg * alpha + ps;
  PK4(p0, 0, pa0); PK4(p0, 8, pa1); PK4(p1, 0, pa2); PK4(p1, 8, pa3);
}
__device__ __forceinline__ void qkt(f32x16& p0, f32x16& p1, const bf16* Ks, const bf16x8* qr, int r32, int hi) {
  p0 = f32x16{}; p1 = f32x16{};
  for (int d0 = 0; d0 < 8; ++d0) { int cb = (d0 * 16 + hi * 8) * 2;
    bf16x8 b0 = *reinterpret_cast<const bf16x8*>((const char*)Ks + KSWZ(r32, cb));
    bf16x8 b1 = *reinterpret_cast<const bf16x8*>((const char*)Ks + KSWZ(32 + r32, cb));
    p0 = __builtin_amdgcn_mfma_f32_32x32x16_bf16(b0, qr[d0], p0, 0, 0, 0);
    p1 = __builtin_amdgcn_mfma_f32_32x32x16_bf16(b1, qr[d0], p1, 0, 0, 0); }
}
__device__ __forceinline__ int v_st(int k, int c) { const int kk = (k & ~0xC) | ((k & 4) << 1) | ((k & 8) >> 1); return ((kk >> 3) * 4 + (c >> 5)) * 512 + ((kk & 7) * 32 + (c & 31)) * 2; }
__device__ __forceinline__ int v_rd_base(int lane) { return ((lane & 3) << 3) | (((lane >> 2) & 3) << 6) | (((lane >> 4) & 1) << 5) | (((lane >> 5) & 1) << 8); }
constexpr int v_rd_off(int d0, int ks, int half) { return d0 * 512 + ks * 4096 + half * 2048; }
template <int OFF> __device__ __forceinline__ s16x4 tr_read(int vb) {
  s16x4 r; asm volatile("ds_read_b64_tr_b16 %0, %1 offset:%2" : "=&v"(r) : "v"(vb), "i"(OFF) : "memory"); return r;
}
#define PKLH(L, H) (bf16x8){L[0], L[1], L[2], L[3], H[0], H[1], H[2], H[3]}
template <int D0> __device__ __forceinline__ void pv_one(f32x16& od, int vb, bf16x8 pa0, bf16x8 pa1, bf16x8 pa2, bf16x8 pa3) {
  const s16x4 l0 = tr_read<v_rd_off(D0, 0, 0)>(vb), h0 = tr_read<v_rd_off(D0, 0, 1)>(vb), l1 = tr_read<v_rd_off(D0, 1, 0)>(vb), h1 = tr_read<v_rd_off(D0, 1, 1)>(vb);
  const s16x4 l2 = tr_read<v_rd_off(D0, 2, 0)>(vb), h2 = tr_read<v_rd_off(D0, 2, 1)>(vb), l3 = tr_read<v_rd_off(D0, 3, 0)>(vb), h3 = tr_read<v_rd_off(D0, 3, 1)>(vb);
  asm volatile("s_waitcnt lgkmcnt(0)" ::: "memory"); SBAR();
  od = __builtin_amdgcn_mfma_f32_32x32x16_bf16(pa0, PKLH(l0, h0), od, 0, 0, 0);
  od = __builtin_amdgcn_mfma_f32_32x32x16_bf16(pa1, PKLH(l1, h1), od, 0, 0, 0);
  od = __builtin_amdgcn_mfma_f32_32x32x16_bf16(pa2, PKLH(l2, h2), od, 0, 0, 0);
  od = __builtin_amdgcn_mfma_f32_32x32x16_bf16(pa3, PKLH(l3, h3), od, 0, 0, 0);
}
__device__ __forceinline__ void pv_d0(f32x16* o, int vb, bf16x8 pa0, bf16x8 pa1, bf16x8 pa2, bf16x8 pa3) {
  pv_one<0>(o[0], vb, pa0, pa1, pa2, pa3); pv_one<1>(o[1], vb, pa0, pa1, pa2, pa3); pv_one<2>(o[2], vb, pa0, pa1, pa2, pa3); pv_one<3>(o[3], vb, pa0, pa1, pa2, pa3);
}

constexpr int LDQ = 1024, LDK = 256, LDO = 1024;
__device__ __forceinline__ void attn_dense_body(const bf16* Qb, const bf16* __restrict__ Kh, const bf16* __restrict__ Vh, bf16* Ob, int seq, char* lds, const float* __restrict__ qn, int qpos0) {
  int tid_ = threadIdx.x; asm volatile("" : "+v"(tid_)); const int tid = tid_, wid = tid >> 6, lane = tid & 63, r32 = lane & 31, hi = lane >> 5;
  bf16* V_lds = (bf16*)lds; bf16* K_lds = (bf16*)(lds + 2 * SHM_V);
  float* ws = (float*)(lds + 2 * SHM_V + 2 * SHM_K) + wid * 64; float* li_l = ws; float* al_l = ws + 32;
  float m_reg = -1e30f, l_reg = 0; f32x16 o[4] = {}; bf16x8 qr[8];
  const bf16* Qw = Qb + (long)(wid * QBLK + r32) * LDQ + hi * 8;
#pragma unroll
  for (int d0 = 0; d0 < 8; ++d0) qr[d0] = ld8(Qw + d0 * 16);
  {
    float xf[8][8]; float ss = 0.f;
#pragma unroll
    for (int d0 = 0; d0 < 8; ++d0)
#pragma unroll
      for (int j = 0; j < 8; ++j) { xf[d0][j] = bf2f((unsigned short)qr[d0][j]); ss = fmaf(xf[d0][j], xf[d0][j], ss); }
    ss += __int_as_float(__builtin_amdgcn_ds_bpermute((lane ^ 32) << 2, __float_as_int(ss)));
    const float rstd = 1.0f / sqrtf(ss * (1.0f / 128.0f) + 1e-6f);
#pragma unroll
    for (int d0 = 0; d0 < 8; ++d0) { const f32x4 g0 = *(const f32x4*)(qn + d0 * 16 + hi * 8), g1 = *(const f32x4*)(qn + d0 * 16 + hi * 8 + 4);
#pragma unroll
      for (int j = 0; j < 4; ++j) { xf[d0][j] *= rstd * g0[j]; xf[d0][4 + j] *= rstd * g1[j]; } }
    if (qpos0 >= 0) { const int t = qpos0 + wid * QBLK + r32; const float pr = (float)(t >> 6), pc = (float)(t & 63);
#pragma unroll
      for (int dd = 0; dd < 2; ++dd)
#pragma unroll
        for (int j = 0; j < 8; ++j) { const float inv = exp2f(-(float)(dd * 16 + hi * 8 + j) * (13.287712379549449f / 32.0f));
          const float s0 = __sinf(pr * inv), c0 = __cosf(pr * inv), s1 = __sinf(pc * inv), c1 = __cosf(pc * inv);
          const float a1 = xf[dd][j], a2 = xf[dd + 2][j], b1 = xf[4 + dd][j], b2 = xf[6 + dd][j];
          xf[dd][j] = a1 * c0 - a2 * s0; xf[dd + 2][j] = a1 * s0 + a2 * c0; xf[4 + dd][j] = b1 * c1 - b2 * s1; xf[6 + dd][j] = b1 * s1 + b2 * c1; } }
#pragma unroll
    for (int d0 = 0; d0 < 8; ++d0) { u32x4 w = {cvtpk(xf[d0][0], xf[d0][1]), cvtpk(xf[d0][2], xf[d0][3]), cvtpk(xf[d0][4], xf[d0][5]), cvtpk(xf[d0][6], xf[d0][7])}; qr[d0] = *reinterpret_cast<bf16x8*>(&w); }
  }
  const int sr = tid >> 4, sc = (tid & 15) * 8, vst0 = v_st(sr, sc), vst1 = v_st(32 + sr, sc);
  const int vb0 = (int)(uintptr_t)V_lds + v_rd_base(lane);
  struct { bf16x8 vs0, vs1, ks0, ks1; } sr_[SDEPTH];
#define SLOAD(i, k0) do { sr_[i].vs0 = ld8(&Vh[(long)((k0) + sr) * LDK + sc]); sr_[i].vs1 = ld8(&Vh[(long)((k0) + 32 + sr) * LDK + sc]); \
    sr_[i].ks0 = ld8(&Kh[(long)((k0) + sr) * LDK + sc]); sr_[i].ks1 = ld8(&Kh[(long)((k0) + 32 + sr) * LDK + sc]); } while (0)
#define SWRITE(b, i) do { *(bf16x8*)((char*)V_lds + (b) * SHM_V + vst0) = sr_[i].vs0;          \
    *(bf16x8*)((char*)V_lds + (b) * SHM_V + vst1) = sr_[i].vs1; int kc = sc * 2;               \
    *(bf16x8*)((char*)K_lds + (b) * SHM_K + KSWZ(sr, kc)) = sr_[i].ks0;                       \
    *(bf16x8*)((char*)K_lds + (b) * SHM_K + KSWZ(32 + sr, kc)) = sr_[i].ks1; } while (0)
#define SWAIT() do { asm volatile("s_waitcnt vmcnt(4)" ::: "memory"); } while (0)
#define RESC(a) do { if (__any((a) < 1.f)) { if (hi == 0) al_l[r32] = (a); asm volatile("s_waitcnt lgkmcnt(0)" ::: "memory"); \
    for (int d = 0; d < 4; ++d) for (int r = 0; r < 16; ++r) o[d][r] *= al_l[crow(r, hi)]; } } while (0)
  f32x16 pA0, pA1, pB0, pB1; float mnA, mnB, alA, alB; bf16x8 pa0, pa1, pa2, pa3; const int NT = seq / KVBLK;
  constexpr int SE = 0, SO = SDEPTH - 1;
  SLOAD(SE, 0); asm volatile("s_waitcnt vmcnt(0)" ::: "memory"); SWRITE(0, SE); __syncthreads();
  qkt(pA0, pA1, K_lds, qr, r32, hi); partialSM(pA0, pA1, m_reg, mnA, alA);
  SLOAD(SO, KVBLK); if (2 < NT) SLOAD(SE, 2 * KVBLK);
  SWAIT(); SWRITE(1, SO); __syncthreads();
  for (int j = 1; j + 1 < NT; j += 2) {
    SBAR(); qkt(pB0, pB1, (bf16*)((char*)K_lds + SHM_K), qr, r32, hi);
    finishSM(pA0, pA1, alA, l_reg, pa0, pa1, pa2, pa3); SBAR();
    SLOAD(SO, (j + SDEPTH) * KVBLK); SBAR();
    pv_d0(o, vb0, pa0, pa1, pa2, pa3); partialSM(pB0, pB1, m_reg, mnB, alB);
    __syncthreads(); SWAIT(); SWRITE(0, SE);
    RESC(alB); __syncthreads();
    SBAR(); qkt(pA0, pA1, K_lds, qr, r32, hi);
    finishSM(pB0, pB1, alB, l_reg, pa0, pa1, pa2, pa3); SBAR();
    if (j + 3 < NT) SLOAD(SE, (j + 1 + SDEPTH) * KVBLK); SBAR();
    pv_d0(o, vb0 + (int)SHM_V, pa0, pa1, pa2, pa3); partialSM(pA0, pA1, m_reg, mnA, alA);
    __syncthreads(); SWAIT(); SWRITE(1, SO);
    RESC(alA); __syncthreads();
  }
  SBAR(); qkt(pB0, pB1, (bf16*)((char*)K_lds + SHM_K), qr, r32, hi);
  finishSM(pA0, pA1, alA, l_reg, pa0, pa1, pa2, pa3); SBAR();
  pv_d0(o, vb0, pa0, pa1, pa2, pa3); partialSM(pB0, pB1, m_reg, mnB, alB);
  __syncthreads(); RESC(alB);
  finishSM(pB0, pB1, alB, l_reg, pa0, pa1, pa2, pa3); SBAR();
  pv_d0(o, vb0 + (int)SHM_V, pa0, pa1, pa2, pa3);
  if (hi == 0) li_l[r32] = l_reg; asm volatile("s_waitcnt lgkmcnt(0)" ::: "memory");
  float rli[16];
#pragma unroll
  for (int r = 0; r < 16; ++r) rli[r] = __builtin_amdgcn_rcpf(li_l[crow(r, hi)]);
  bf16* Ow = Ob + (long)(wid * QBLK) * LDO;
#pragma unroll
  for (int r = 0; r < 16; ++r) { int orow = crow(r, hi);
#pragma unroll
    for (int d0 = 0; d0 < 4; ++d0) Ow[(long)orow * LDO + d0 * 32 + r32] = f2bf(o[d0][r] * rli[r]); }
  __syncthreads();
#undef SLOAD
#undef SWRITE
#undef SWAIT
#undef RESC
}

__device__ __forceinline__ void ret_summary_unit(const bf16* __restrict__ Rb, unsigned short* KV, long rowbase, int h, float lgf, float lgb, char* lds) {
  int tid_ = threadIdx.x; asm volatile("" : "+v"(tid_)); const int tid = tid_, wid = tid >> 6, lane = tid & 63, r32 = lane & 31, hi = lane >> 5;
  const int dir = wid >> 2, db = wid & 3;
  char* Kim = lds; char* Vf = lds + 16384; char* Vb = lds + 32768;
  const int sr = tid >> 4, sc = (tid & 15) * 8, vst0 = v_st(sr, sc), vst1 = v_st(32 + sr, sc);
  const int vbK = (int)(uintptr_t)Kim + v_rd_base(lane) + db * 512;
  const int vbV = (int)(uintptr_t)(dir ? Vb : Vf) + v_rd_base(lane);
  f32x16 acc[4] = {};
  const bf16* Kp = Rb + rowbase * 2048 + 512 + h * 128 + sc; const bf16* Vp = Rb + rowbase * 2048 + 1024 + h * 128 + sc;
  bf16x8 nk0 = ld8(Kp + (long)sr * 2048), nk1 = ld8(Kp + (long)(sr + 32) * 2048), nv0 = ld8(Vp + (long)sr * 2048), nv1 = ld8(Vp + (long)(sr + 32) * 2048);
  for (int tile = 0; tile < 4; ++tile) {
    const int j0 = tile * 64 + sr, j1 = j0 + 32;
    const bf16x8 k0 = nk0, k1 = nk1, v0 = nv0, v1 = nv1;
    if (tile < 3) { nk0 = ld8(Kp + (long)(j0 + 64) * 2048); nk1 = ld8(Kp + (long)(j1 + 64) * 2048); nv0 = ld8(Vp + (long)(j0 + 64) * 2048); nv1 = ld8(Vp + (long)(j1 + 64) * 2048); }
    const float wf0 = __builtin_amdgcn_exp2f(lgf * (float)(255 - j0)), wf1 = __builtin_amdgcn_exp2f(lgf * (float)(255 - j1));
    const float wb0 = __builtin_amdgcn_exp2f(lgb * (float)j0), wb1 = __builtin_amdgcn_exp2f(lgb * (float)j1);
    u32x4 f0, f1, b0, b1;
#pragma unroll
    for (int q = 0; q < 4; ++q) { const float x0 = bf2f((unsigned short)v0[2 * q]), x1 = bf2f((unsigned short)v0[2 * q + 1]), y0 = bf2f((unsigned short)v1[2 * q]), y1 = bf2f((unsigned short)v1[2 * q + 1]);
      f0[q] = cvtpk(x0 * wf0, x1 * wf0); b0[q] = cvtpk(x0 * wb0, x1 * wb0); f1[q] = cvtpk(y0 * wf1, y1 * wf1); b1[q] = cvtpk(y0 * wb1, y1 * wb1); }
    *(bf16x8*)(Kim + vst0) = k0; *(bf16x8*)(Kim + vst1) = k1;
    *(u32x4*)(Vf + vst0) = f0; *(u32x4*)(Vf + vst1) = f1; *(u32x4*)(Vb + vst0) = b0; *(u32x4*)(Vb + vst1) = b1;
    __syncthreads();
#define RS_STEP(KS) do { const s16x4 al = tr_read<v_rd_off(0, KS, 0)>(vbK), ah = tr_read<v_rd_off(0, KS, 1)>(vbK); \
      const s16x4 l0 = tr_read<v_rd_off(0, KS, 0)>(vbV), h0 = tr_read<v_rd_off(0, KS, 1)>(vbV), l1 = tr_read<v_rd_off(1, KS, 0)>(vbV), h1 = tr_read<v_rd_off(1, KS, 1)>(vbV); \
      const s16x4 l2 = tr_read<v_rd_off(2, KS, 0)>(vbV), h2 = tr_read<v_rd_off(2, KS, 1)>(vbV), l3 = tr_read<v_rd_off(3, KS, 0)>(vbV), h3 = tr_read<v_rd_off(3, KS, 1)>(vbV); \
      asm volatile("s_waitcnt lgkmcnt(0)" ::: "memory"); SBAR(); const bf16x8 af = PKLH(al, ah); \
      acc[0] = __builtin_amdgcn_mfma_f32_32x32x16_bf16(af, PKLH(l0, h0), acc[0], 0, 0, 0); acc[1] = __builtin_amdgcn_mfma_f32_32x32x16_bf16(af, PKLH(l1, h1), acc[1], 0, 0, 0); \
      acc[2] = __builtin_amdgcn_mfma_f32_32x32x16_bf16(af, PKLH(l2, h2), acc[2], 0, 0, 0); acc[3] = __builtin_amdgcn_mfma_f32_32x32x16_bf16(af, PKLH(l3, h3), acc[3], 0, 0, 0); } while (0)
    RS_STEP(0); RS_STEP(1); RS_STEP(2); RS_STEP(3);
#undef RS_STEP
    __syncthreads();
  }
  unsigned short* out = KV + (size_t)dir * 16384;
#pragma unroll
  for (int eb = 0; eb < 4; ++eb)
#pragma unroll
    for (int g = 0; g < 4; ++g) { u32x2 w = {pg8::pk_h2(acc[eb][4 * g], acc[eb][4 * g + 1]), pg8::pk_h2(acc[eb][4 * g + 2], acc[eb][4 * g + 3])};
      *(u32x2*)(out + (size_t)(32 * eb + r32) * 128 + 32 * db + 8 * g + 4 * hi) = w; }
}

template <int CTRL> __device__ __forceinline__ float dppf(float x) { return __builtin_bit_cast(float, __builtin_amdgcn_mov_dpp(__builtin_bit_cast(int, x), CTRL, 0xf, 0xf, true)); }
__device__ __forceinline__ float half32_sum(float x) {
  x += dppf<0xB1>(x); x += dppf<0x4E>(x); x += dppf<0x124>(x); x += dppf<0x128>(x);
  auto s = __builtin_amdgcn_permlane16_swap(__float_as_uint(x), __float_as_uint(x), false, false);
  return __uint_as_float(s[0]) + __uint_as_float(s[1]);
}
__device__ __forceinline__ void ret_output_unit(const bf16* __restrict__ Rb, const bf16* __restrict__ Sf, const bf16* __restrict__ Sb, bf16* Y, long rowbase, int h, float lgf, float lgb, char* lds) {
  int tid_ = threadIdx.x; asm volatile("" : "+v"(tid_)); const int tid = tid_, wid = tid >> 6, lane = tid & 63, r32 = lane & 31, hi = lane >> 5;
  bf16* V_lds = (bf16*)lds; bf16* K_lds = (bf16*)(lds + SHM_V);
  const int a = wid * QBLK + r32;
  f32x16 o[4] = {}; bf16x8 qr[8];
  const bf16* Qw = Rb + (rowbase + a) * 2048 + h * 128 + hi * 8;
#pragma unroll
  for (int d0 = 0; d0 < 8; ++d0) qr[d0] = ld8(Qw + d0 * 16);
  const int sr = tid >> 4, sc = (tid & 15) * 8, vst0 = v_st(sr, sc), vst1 = v_st(32 + sr, sc);
  const int vb0 = (int)(uintptr_t)V_lds + v_rd_base(lane);
  const bf16* Kp = Rb + rowbase * 2048 + 512 + h * 128 + sc; const bf16* Vp = Rb + rowbase * 2048 + 1024 + h * 128 + sc;
  bf16x8 nk0 = ld8(Kp + (long)sr * 2048), nk1 = ld8(Kp + (long)(sr + 32) * 2048), nv0 = ld8(Vp + (long)sr * 2048), nv1 = ld8(Vp + (long)(sr + 32) * 2048);
  if (Sf != nullptr) {
    char* S_lds = lds + 2 * SHM_V;
    { bf16x8 st_[2][4];
#pragma unroll
      for (int dir = 0; dir < 2; ++dir)
#pragma unroll
        for (int i = 0; i < 4; ++i) st_[dir][i] = ld8((dir ? Sb : Sf) + (size_t)(sr + 32 * i) * 128 + sc);
#pragma unroll
      for (int dir = 0; dir < 2; ++dir)
#pragma unroll
        for (int i = 0; i < 4; ++i) *(bf16x8*)(S_lds + dir * 32768 + KSWZ(sr + 32 * i, sc * 2)) = st_[dir][i]; }
    __syncthreads();
    const float sf = __builtin_amdgcn_exp2f(lgf * (float)(a + 1)), sb = __builtin_amdgcn_exp2f(lgb * (float)(256 - a));
#pragma unroll
    for (int dir = 0; dir < 2; ++dir) { const float sc_ = dir ? sb : sf; const char* St = S_lds + dir * 32768;
#pragma unroll
      for (int d0 = 0; d0 < 8; ++d0) { u32x4 w;
#pragma unroll
        for (int q = 0; q < 4; ++q) w[q] = cvtpk(bf2f((unsigned short)qr[d0][2 * q]) * sc_, bf2f((unsigned short)qr[d0][2 * q + 1]) * sc_);
        const bf16x8 qs = *reinterpret_cast<bf16x8*>(&w); const int cb = (d0 * 16 + hi * 8) * 2;
#pragma unroll
        for (int eb = 0; eb < 4; ++eb) o[eb] = __builtin_amdgcn_mfma_f32_32x32x16_bf16(qs, *reinterpret_cast<const bf16x8*>(St + KSWZ(32 * eb + r32, cb)), o[eb], 0, 0, 0); } }
  }
  for (int tile = 0; tile < 4; ++tile) {
    const long j0 = tile * 64 + sr, j1 = j0 + 32;
    const bf16x8 k0 = nk0, k1 = nk1, v0 = nv0, v1 = nv1;
    if (tile < 3) { nk0 = ld8(Kp + (j0 + 64) * 2048); nk1 = ld8(Kp + (j1 + 64) * 2048); nv0 = ld8(Vp + (j0 + 64) * 2048); nv1 = ld8(Vp + (j1 + 64) * 2048); }
    *(bf16x8*)((char*)V_lds + vst0) = v0; *(bf16x8*)((char*)V_lds + vst1) = v1;
    *(bf16x8*)((char*)K_lds + KSWZ(sr, sc * 2)) = k0; *(bf16x8*)((char*)K_lds + KSWZ(32 + sr, sc * 2)) = k1;
    __syncthreads();
    f32x16 p0, p1; qkt(p0, p1, K_lds, qr, r32, hi);
#pragma unroll
    for (int r = 0; r < 16; ++r) {
      const int ja = tile * 64 + crow(r, hi), jb = ja + 32; const float da = (float)(a - ja), db_ = (float)(a - jb);
      const float wa = (da >= 0.f ? __builtin_amdgcn_exp2f(lgf * da) : 0.f) + (da <= 0.f ? __builtin_amdgcn_exp2f(-lgb * da) : 0.f);
      const float wb = (db_ >= 0.f ? __builtin_amdgcn_exp2f(lgf * db_) : 0.f) + (db_ <= 0.f ? __builtin_amdgcn_exp2f(-lgb * db_) : 0.f);
      p0[r] *= wa * SCALE; p1[r] *= wb * SCALE; }
    bf16x8 pa0, pa1, pa2, pa3; PK4(p0, 0, pa0); PK4(p0, 8, pa1); PK4(p1, 0, pa2); PK4(p1, 8, pa3);
    pv_d0(o, vb0, pa0, pa1, pa2, pa3);
    __syncthreads();
  }
  const bf16* Gp = Rb + (rowbase + wid * QBLK) * 2048 + 1536 + h * 128; bf16* Yp = Y + (rowbase + wid * QBLK) * 512 + h * 128;
  unsigned short gq[16][4];
#pragma unroll
  for (int r = 0; r < 16; ++r)
#pragma unroll
    for (int eb = 0; eb < 4; ++eb) gq[r][eb] = Gp[(long)crow(r, hi) * 2048 + 32 * eb + r32];
#pragma unroll
  for (int r = 0; r < 16; ++r) {
    float ss = o[0][r] * o[0][r] + o[1][r] * o[1][r] + o[2][r] * o[2][r] + o[3][r] * o[3][r];
    ss = half32_sum(ss);
    const float rs = __builtin_amdgcn_rsqf(ss * (1.0f / 128.0f) + 1e-6f); const int row = crow(r, hi);
#pragma unroll
    for (int eb = 0; eb < 4; ++eb) { const float g = bf2f(gq[r][eb]);
      const float sg = g * __builtin_amdgcn_rcpf(1.0f + __builtin_amdgcn_exp2f(-1.4426950408889634f * g));
      Yp[(long)row * 512 + 32 * eb + r32] = f2bf(o[eb][r] * rs * sg); } }
}
#undef PK4
#undef PKLH
#undef KSWZ
#undef SBAR
}
constexpr int NWAVES = 8, NTHR = 512;
constexpr int DM = 2048, NB = 16, SEQ = 2048, CTXL = 256, FFN = 5632, NMOD = 9, NMODC = NMOD * DM;
constexpr int TLAT = NB * SEQ, TCTX = NB * CTXL, TALL = TLAT + TCTX;
constexpr int NCAT = 3584 + 6144;
constexpr int KVROWS = SEQ + CTXL;
constexpr size_t MiB = 1u << 20;
constexpr size_t W_GU1 = 0, W_D1 = W_GU1 + (size_t)2 * FFN * DM, W_CAT = W_D1 + (size_t)DM * FFN, W_FOLD = W_CAT + (size_t)NCAT * DM, W_BF = W_FOLD + (size_t)1024 * DM,
                 W_BA = W_BF + (size_t)DM * 512, W_BR = W_BA + (size_t)DM * 1024, W_OUT = W_BR + (size_t)DM * 512, W_GU2 = W_OUT + (size_t)DM * DM, W_D2 = W_GU2 + (size_t)2 * FFN * DM,
                 W_END = W_D2 + (size_t)DM * FFN;
constexpr size_t WS_CTL = 0, CTL_ZERO_BYTES = 1 * MiB;
constexpr size_t WS_MOD = 1 * MiB;
constexpr size_t WS_AMAT = 4 * MiB;
constexpr size_t WS_AMATC = WS_AMAT + 16 * MiB;
constexpr size_t WS_HCTX = 21 * MiB;
constexpr size_t WS_W = 53 * MiB;
constexpr size_t WS_XN = 246 * MiB;
constexpr size_t WS_R = 390 * MiB;
constexpr size_t R_H = 0;
constexpr size_t R_Q = 0;
constexpr size_t R_K = 72 * MiB, R_V = 90 * MiB;
constexpr size_t R_RB = 108 * MiB;
constexpr size_t R_PTL = 252 * MiB, R_PTC = 316 * MiB;
constexpr size_t R_G = 324 * MiB;
constexpr size_t R_YR = 756 * MiB, R_YF = 792 * MiB, R_END = 828 * MiB;
constexpr size_t R_MODP = 0;
constexpr size_t X_KV = 0, X_ST = 76 * MiB;
constexpr size_t WS_END = WS_R + R_END;
static_assert(W_END * 2 <= (WS_XN - WS_W) && WS_MOD + (size_t)2 * 17 * NMODC * 4 <= WS_AMAT && WS_AMATC + 256 * 512 * 2 <= WS_HCTX && WS_HCTX + (size_t)TCTX * DM * 4 <= WS_W, "ws map 1");
static_assert((size_t)TALL * FFN * 2 <= R_END && R_G + (size_t)TALL * 6144 * 2 <= R_YR && X_ST + (size_t)64 * 8 * 2 * 16384 * 2 <= 144 * MiB && (size_t)64 * 9 * 2 * 16384 * 4 <= X_ST, "ws map 2");
constexpr int CW_TMO = 0, CW_BAR = 4096;
constexpr int RING_BYTES = 131072, MISC_OFF = RING_BYTES + 320, LDS_BYTES = 147456;

#define LAS __attribute__((address_space(3)))
typedef unsigned short bf16;
typedef unsigned v4u __attribute__((ext_vector_type(4)));
typedef unsigned v2u __attribute__((ext_vector_type(2)));
typedef float f32x4 __attribute__((ext_vector_type(4)));
__device__ __forceinline__ unsigned pk2(float lo, float hi) { return pg8::cvt_pk_bf16(lo, hi); }
__device__ __forceinline__ float bflo(unsigned w) { return __uint_as_float(w << 16); }
__device__ __forceinline__ float bfhi(unsigned w) { return __uint_as_float(w & 0xffff0000u); }
#define XB_TMO      128
#define XB_XCNT(j)  (256  + 64 * (j))
#define XB_XSUB(j)  (1280 + 64 * (j))
#define XB_XGEN(j)  (2304 + 64 * (j))
#define XB_TOP      3328
#define XB_TOPGEN   3392
#define XCD_BAR_WORDS 3456
#define XB_SPIN_CAP (1u << 18)

__device__ __forceinline__ unsigned xb_ld(unsigned* p)              { return __hip_atomic_load(p, __ATOMIC_RELAXED, __HIP_MEMORY_SCOPE_AGENT); }
__device__ __forceinline__ unsigned xb_add(unsigned* p, unsigned v) { return __hip_atomic_fetch_add(p, v, __ATOMIC_RELAXED, __HIP_MEMORY_SCOPE_AGENT); }
__device__ __forceinline__ unsigned xb_xcc_id() { return (unsigned)__builtin_amdgcn_s_getreg((3 << 11) | 20) & 0xFu; }
#define XB_SPIN(cond, bar) do { unsigned _sp = 0; while (cond) { __builtin_amdgcn_s_sleep(1); \
    if ((++_sp & 255u) == 0u) { if (xb_ld(&(bar)[XB_TMO])) break; if (_sp > XB_SPIN_CAP) { atomicAdd(&(bar)[XB_TMO], 1u); break; } } } } while (0)

struct XcdBarrier {
    unsigned* bar; unsigned x;
    volatile LAS unsigned* st;
};

__device__ __forceinline__ XcdBarrier xcd_barrier_post(unsigned* bar, volatile LAS unsigned* st) {
    XcdBarrier b; b.bar = bar; b.x = xb_xcc_id(); b.st = st;
    if (threadIdx.x == 0) (void)xb_add(&bar[XB_XCNT(b.x)], 1u);
    return b;
}
__device__ __forceinline__ void xcd_barrier_complete(unsigned* bar, unsigned x, unsigned& nloc, unsigned& nx) {
    const unsigned G = gridDim.x * gridDim.y * gridDim.z;
    unsigned sum, cnt, mine, sp = 0u;
    for (;;) {
        sum = 0u; cnt = 0u; mine = 0u;
        unsigned cv[16];
#pragma unroll
        for (unsigned j = 0; j < 16; ++j) cv[j] = xb_ld(&bar[XB_XCNT(j)]);
#pragma unroll
        for (unsigned j = 0; j < 16; ++j) { const unsigned c = cv[j]; sum += c; cnt += (c > 0u) ? 1u : 0u; mine = (j == x) ? c : mine; }
        if (sum == G) break;
        __builtin_amdgcn_s_sleep(1);
        if ((++sp & 255u) == 0u) { if (xb_ld(&bar[XB_TMO])) break; if (sp > XB_SPIN_CAP) { atomicAdd(&bar[XB_TMO], 1u); break; } }
    }
    nloc = mine > 0u ? mine : 1u; nx = cnt > 0u ? cnt : 1u;
}

__device__ __forceinline__ void xcd_barrier(const XcdBarrier& b) {
    asm volatile("s_waitcnt vmcnt(0)" ::: "memory");
    __syncthreads();
    if (threadIdx.x == 0) {
        unsigned* bar = b.bar;
        __builtin_amdgcn_s_waitcnt(0);
        unsigned nloc = b.st[0], nx = b.st[1];
        if (nloc == 0u) { xcd_barrier_complete(bar, b.x, nloc, nx); b.st[0] = nloc; b.st[1] = nx; }
        const unsigned old = xb_add(&bar[XB_XSUB(b.x)], 1u);
        const unsigned gen = old / nloc;
        if (old + 1u == (gen + 1u) * nloc) {
            __builtin_amdgcn_fence(__ATOMIC_RELEASE, "agent");
            asm volatile("s_waitcnt vmcnt(0)" ::: "memory");
            const unsigned og = xb_add(&bar[XB_TOP], 1u);
            const unsigned tg = og / nx;
            if (og + 1u == (tg + 1u) * nx) xb_add(&bar[XB_TOPGEN], 1u);
            else XB_SPIN(xb_ld(&bar[XB_TOPGEN]) == tg, bar);
            __builtin_amdgcn_fence(__ATOMIC_ACQUIRE, "agent");
            xb_add(&bar[XB_XGEN(b.x)], 1u);
            asm volatile("s_waitcnt vmcnt(0)" ::: "memory");
        } else {
            XB_SPIN(xb_ld(&bar[XB_XGEN(b.x)]) == gen, bar);
            __builtin_amdgcn_fence(__ATOMIC_ACQUIRE, "agent");
            asm volatile("s_waitcnt vmcnt(0)" ::: "memory");
        }
    }
    __syncthreads();
}
#define LDS_WAIT() asm volatile("s_waitcnt lgkmcnt(0)" ::: "memory")
__device__ __forceinline__ float hlo(unsigned w) { return (float)__builtin_bit_cast(pg8::f16x2, w)[0]; }
__device__ __forceinline__ float hhi(unsigned w) { return (float)__builtin_bit_cast(pg8::f16x2, w)[1]; }
struct Frame { LAS unsigned char* lds; unsigned char* ldsg; int tid, lane, wave, vcu, G; };
__device__ __forceinline__ float shx(float v, int lane, int o) { return __int_as_float(__builtin_amdgcn_ds_bpermute((lane ^ o) << 2, __float_as_int(v))); }
__device__ __forceinline__ float wave_sum(float v, int lane) {
#pragma unroll
    for (int o = 1; o < 64; o <<= 1) v += shx(v, lane, o);
    return v;
}
__device__ __forceinline__ float silu_f(float x) { return x / (1.0f + __expf(-x)); }

__device__ __forceinline__ void p_adaln_partial(const Frame& F, const float* __restrict__ c, const float* __restrict__ cctx, const float* __restrict__ w_ada, float* modp) {
    LAS float* ca = (LAS float*)(F.lds + F.wave * 10240);
    const int gw = F.vcu * NWAVES + F.wave, NGW = F.G * NWAVES;
    for (int it = gw; it < 2 * 72 * 16; it += NGW) {
        const int ks = it & 15, cb = (it >> 4) % 72, l = it / (72 * 16), k0 = ks * 128;
        for (int i = 0; i < 34; ++i) { const int idx = F.lane + 64 * i, r = idx >> 7, kk = idx & 127;
            const float x = (r < 16) ? c[r * DM + k0 + kk] : cctx[k0 + kk]; ca[kk * 20 + r] = silu_f(x); }
        LDS_WAIT();
        f32x4 acc[17];
#pragma unroll
        for (int r = 0; r < 17; ++r) acc[r] = (f32x4){0.f, 0.f, 0.f, 0.f};
        const float* wp = w_ada + ((size_t)l * DM + k0) * NMODC + cb * 256 + F.lane * 4;
#pragma unroll 4
        for (int kk = 0; kk < 128; ++kk) {
            const f32x4 w = *(const f32x4*)(wp + (size_t)kk * NMODC);
            const LAS f32x4* cp = (const LAS f32x4*)(ca + kk * 20); const f32x4 c0 = cp[0], c1 = cp[1], c2 = cp[2], c3 = cp[3]; const float c16 = ca[kk * 20 + 16];
#pragma unroll
            for (int j = 0; j < 4; ++j) { acc[j] += c0[j] * w; acc[4 + j] += c1[j] * w; acc[8 + j] += c2[j] * w; acc[12 + j] += c3[j] * w; }
            acc[16] += c16 * w; }
        float* op = modp + ((size_t)(l * 16 + ks) * 17) * NMODC + cb * 256 + F.lane * 4;
#pragma unroll
        for (int r = 0; r < 17; ++r) *(f32x4*)(op + (size_t)r * NMODC) = acc[r];
        LDS_WAIT();
    }
}
__device__ __forceinline__ void p_mod_finalize(const Frame& F, const float* __restrict__ b_ada, const float* __restrict__ modp, float* mod) {
    const int n4 = 2 * 17 * (NMODC / 4);
    for (int i = F.vcu * NTHR + F.tid; i < n4; i += F.G * NTHR) { const int l = i / (17 * (NMODC / 4)), rem = i % (17 * (NMODC / 4)), r = rem / (NMODC / 4), c4 = rem % (NMODC / 4);
        f32x4 s = *(const f32x4*)(b_ada + (size_t)l * NMODC + c4 * 4);
        for (int ks = 0; ks < 16; ++ks) s += *(const f32x4*)(modp + ((size_t)(l * 16 + ks) * 17 + r) * NMODC + c4 * 4);
        *(f32x4*)(mod + ((size_t)l * 17 + r) * NMODC + c4 * 4) = s; }
}
__device__ __forceinline__ void cvt_load(f32x4 (&v)[8], const float* __restrict__ W, int ldw, int k0, int n0, int lane) {
    const int r8 = lane >> 3, c4 = lane & 7;
#pragma unroll
    for (int i = 0; i < 8; ++i) v[i] = *(const f32x4*)(W + (size_t)(k0 + 8 * i + r8) * ldw + n0 + 4 * c4);
}
__device__ __forceinline__ void cvt_to_lds(const f32x4 (&v)[8], LAS float* scr, int lane) {
    const int r8 = lane >> 3, c4 = lane & 7;
#pragma unroll
    for (int i = 0; i < 8; ++i)
#pragma unroll
        for (int j = 0; j < 4; ++j) scr[(4 * c4 + j) * 65 + 8 * i + r8] = v[i][j];
}
__device__ __forceinline__ void cvt_store(int K, bf16* WT, int drow0, int k0, LAS float* scr, int lane) {
    const int r8 = lane >> 3, c4 = lane & 7;
#pragma unroll
    for (int jj = 0; jj < 4; ++jj) { const int n = r8 + 8 * jj; const LAS float* s = scr + n * 65 + 8 * c4;
        v4u o; o.x = pk2(s[0], s[1]); o.y = pk2(s[2], s[3]); o.z = pk2(s[4], s[5]); o.w = pk2(s[6], s[7]);
        const int dr = drow0 + n;
        *(v4u*)(WT + ((size_t)((dr >> 8) * (K / 64) + (k0 >> 6)) * 256 + (dr & 255)) * 64 + 8 * c4) = o; }
}
struct WSrc { const float *g1, *u1, *d1, *win, *wmg, *wbf, *wba, *wbr, *wout, *g2, *u2, *d2; };
__device__ __forceinline__ void cvt_decode(int r, const WSrc& S, bf16* Wb, unsigned mask, const float*& W, int& ldw, int& K, bf16*& WT, int& drow0, int& k0, int& n0) {
    bool found = false; W = S.g1; ldw = FFN; K = DM; WT = Wb; drow0 = 0; k0 = 0; n0 = 0;
#define CV_SEG(k, SRC, LDW, KK, NC, DST, MODE) if (!found && ((mask >> (k)) & 1u)) { const int nblk = (NC) / 32, items = ((KK) / 64) * nblk; \
        if (r < items) { found = true; W = (SRC); ldw = (LDW); K = (KK); WT = (DST); const int kb = r / nblk, nb = r % nblk; n0 = nb * 32; k0 = kb * 64; \
            drow0 = ((MODE) == 0) ? n0 : ((n0 >> 7) * 256 + (n0 & 127) + ((MODE) == 2 ? 128 : 0)); } else r -= items; }
    CV_SEG(0, S.g1, FFN, DM, FFN, Wb + W_GU1, 1) CV_SEG(1, S.u1, FFN, DM, FFN, Wb + W_GU1, 2) CV_SEG(2, S.d1, DM, FFN, DM, Wb + W_D1, 0)
    CV_SEG(3, S.win, 4096, DM, 3584, Wb + W_CAT, 0) CV_SEG(4, S.wmg, 6144, DM, 6144, Wb + W_CAT + (size_t)3584 * DM, 0)
    CV_SEG(5, S.wbf, DM, 512, DM, Wb + W_BF, 0) CV_SEG(6, S.wba, DM, 1024, DM, Wb + W_BA, 0) CV_SEG(7, S.wbr, DM, 512, DM, Wb + W_BR, 0) CV_SEG(8, S.wout, DM, DM, DM, Wb + W_OUT, 0)
    CV_SEG(9, S.g2, FFN, DM, FFN, Wb + W_GU2, 1) CV_SEG(10, S.u2, FFN, DM, FFN, Wb + W_GU2, 2) CV_SEG(11, S.d2, DM, FFN, DM, Wb + W_D2, 0)
#undef CV_SEG
}
__device__ __forceinline__ void p_convert(const Frame& F, const WSrc& S, bf16* Wb, unsigned mask) {
    LAS float* scr = (LAS float*)(F.lds + F.wave * 16384);
    const int gw = F.vcu * NWAVES + F.wave, NGW = F.G * NWAVES;
    constexpr int IT_GU = (DM / 64) * (FFN / 32), IT_D = (FFN / 64) * (DM / 32), IT_IN = (DM / 64) * (3584 / 32), IT_MG = (DM / 64) * (6144 / 32), IT_B5 = (512 / 64) * (DM / 32), IT_B10 = (1024 / 64) * (DM / 32), IT_O = (DM / 64) * (DM / 32);
#define ON(k) ((mask >> (k)) & 1u)
    const int NIT = (int)(ON(0) + ON(1) + ON(9) + ON(10)) * IT_GU + (int)(ON(2) + ON(11)) * IT_D + (int)ON(3) * IT_IN + (int)ON(4) * IT_MG + (int)(ON(5) + ON(7)) * IT_B5 + (int)ON(6) * IT_B10 + (int)ON(8) * IT_O;
#undef ON
    if (gw >= NIT) return;
    const float* W; int ldw, K, drow0, k0, n0; bf16* WT; f32x4 v[8];
    cvt_decode(gw, S, Wb, mask, W, ldw, K, WT, drow0, k0, n0); cvt_load(v, W, ldw, k0, n0, F.lane);
    for (int it = gw; it < NIT; it += NGW) {
        cvt_to_lds(v, scr, F.lane);
        const int Kc = K, drc = drow0, k0c = k0; bf16* WTc = WT;
        if (it + NGW < NIT) { cvt_decode(it + NGW, S, Wb, mask, W, ldw, K, WT, drow0, k0, n0); cvt_load(v, W, ldw, k0, n0, F.lane); }
        LDS_WAIT();
        cvt_store(Kc, WTc, drc, k0c, scr, F.lane);
        LDS_WAIT();
    }
}
__device__ __forceinline__ void p_fold(const Frame& F, const float* __restrict__ win, bf16* Wfold) {
    LAS float* wt = (LAS float*)F.lds; LAS float* ct = (LAS float*)(F.lds + 64 * 129 * 4);
    for (int item = F.vcu; item < 128; item += F.G) {
        const int g = item >> 5, k0 = (item & 31) * 64;
        __syncthreads();
        for (int i = 0; i < 16; ++i) { const int idx = F.tid + NTHR * i, kk = idx >> 7, cc = idx & 127; wt[kk * 129 + cc] = win[(size_t)(k0 + kk) * 4096 + 3584 + g * 128 + cc]; }
        if (F.tid < 128) ct[F.tid] = __builtin_amdgcn_cosf((float)F.tid * (1.0f / 128.0f));
        __syncthreads();
        const int fl = F.tid & 127, kk0 = (F.tid >> 7) * 16, ty = fl >> 6, j = fl & 63, kf = (ty && j == 0) ? 64 : j; const bool issin = ty && j;
        float acc[16];
#pragma unroll
        for (int kk = 0; kk < 16; ++kk) acc[kk] = 0.f;
        for (int cc = 0; cc < 128; ++cc) { const int t = (cc * kf) & 127; const float tw = ct[issin ? ((t - 32) & 127) : t];
#pragma unroll
            for (int kk = 0; kk < 16; ++kk) acc[kk] += wt[(kk0 + kk) * 129 + cc] * tw; }
        const int f = g * 128 + fl;
        bf16* op = Wfold + ((size_t)((f >> 8) * (DM / 64) + (k0 >> 6)) * 256 + (f & 255)) * 64 + kk0;
#pragma unroll
        for (int q = 0; q < 2; ++q) { v4u o; o.x = pk2(acc[8 * q], acc[8 * q + 1]); o.y = pk2(acc[8 * q + 2], acc[8 * q + 3]); o.z = pk2(acc[8 * q + 4], acc[8 * q + 5]); o.w = pk2(acc[8 * q + 6], acc[8 * q + 7]); *(v4u*)(op + 8 * q) = o; }
    }
    __syncthreads();
}
__device__ __forceinline__ void p_wbf_fold(const Frame& F, const float* __restrict__ wbf, bf16* WT) {
    for (int i = F.vcu * NTHR + F.tid; i < 2048 * 64; i += F.G * NTHR) { const int n = i & 2047, kb = i >> 11;
        const int g = kb >> 4, ty = (kb >> 3) & 1, j0 = (kb & 7) * 8; float v[8];
#pragma unroll
        for (int e = 0; e < 8; ++e) { const int j = j0 + e; const int r1 = g * 128 + (j == 0 ? (ty ? 64 : 0) : (ty ? 128 - j : j)), r2 = g * 128 + (j == 0 ? 0 : (ty ? j : 128 - j));
            const float a = wbf[(size_t)r1 * DM + n], bq = wbf[(size_t)r2 * DM + n]; v[e] = (j == 0) ? a : (ty ? a - bq : a + bq); }
        v4u o; o.x = pk2(v[0], v[1]); o.y = pk2(v[2], v[3]); o.z = pk2(v[4], v[5]); o.w = pk2(v[6], v[7]);
        *(v4u*)(WT + ((size_t)((n >> 8) * 8 + (kb >> 3)) * 256 + (n & 255)) * 64 + (kb & 7) * 8) = o; }
}
__device__ __forceinline__ void p_consts(const Frame& F, bf16* Amat, bf16* AmatC) {
    LAS float* tab = (LAS float*)F.lds;
    __syncthreads();
    for (int i = F.tid; i < 2048; i += NTHR) tab[i] = __builtin_amdgcn_cosf((float)i * (1.0f / 2048.0f));
    __syncthreads();
    const int h8 = 2048 * 2048 / 8, h8c = 256 * 256 / 8;
    for (int i = F.vcu * NTHR + F.tid; i < 2 * h8 + 2 * h8c; i += F.G * NTHR) {
        float v[8]; bf16* dst;
        if (i < 2 * h8) { const int cs = i >= h8, ii = cs ? i - h8 : i, t = ii >> 8, s0 = (ii & 255) * 8; dst = Amat + (size_t)i * 8;
#pragma unroll
            for (int e = 0; e < 8; ++e) { const int j = (t * (s0 + e)) & 2047; v[e] = cs ? tab[(j - 512) & 2047] : tab[j]; } }
        else { const int i2 = i - 2 * h8, cs = i2 >= h8c, ii = cs ? i2 - h8c : i2, t = ii >> 5, s0 = (ii & 31) * 8; dst = AmatC + (size_t)i2 * 8;
#pragma unroll
            for (int e = 0; e < 8; ++e) { const int j = (8 * t * (s0 + e)) & 2047; v[e] = cs ? tab[(j - 512) & 2047] : tab[j]; } }
        v4u o; o.x = pk2(v[0], v[1]); o.y = pk2(v[2], v[3]); o.z = pk2(v[4], v[5]); o.w = pk2(v[6], v[7]); *(v4u*)dst = o;
    }
    __syncthreads();
}
template <bool SRC16> __device__ __forceinline__ void p_norm(const Frame& F, const void* hlat, const void* hctx, const float* __restrict__ gain, const float* __restrict__ modl, int ish, int isc, int nrows, bf16* XN) {
    const int gw = F.vcu * NWAVES + F.wave, NGW = F.G * NWAVES, chunk = (nrows + NGW - 1) / NGW, r0 = gw * chunk, r1 = (r0 + chunk < nrows) ? r0 + chunk : nrows;
    f32x4 av[8], sv[8]; int cur = -1;
    for (int r = r0; r < r1; ++r) {
        const int rb = (r < TLAT) ? (r >> 11) : 16;
        if (rb != cur) { cur = rb; const float* mp = modl + (size_t)rb * NMODC;
#pragma unroll
            for (int j = 0; j < 8; ++j) { const int col = F.lane * 4 + 256 * j; const f32x4 g = *(const f32x4*)(gain + col), sc = *(const f32x4*)(mp + isc * DM + col); av[j] = g * (sc + 1.0f); sv[j] = *(const f32x4*)(mp + ish * DM + col); } }
        f32x4 v[8]; float ss = 0.f;
        if (SRC16) { const bf16* src = (r < TLAT) ? (const bf16*)hlat + (size_t)r * DM : (const bf16*)hctx + (size_t)(r - TLAT) * DM;
            v2u w[8];
#pragma unroll
            for (int j = 0; j < 8; ++j) w[j] = *(const v2u*)(src + F.lane * 4 + 256 * j);
#pragma unroll
            for (int j = 0; j < 8; ++j) v[j] = (f32x4){hlo(w[j].x), hhi(w[j].x), hlo(w[j].y), hhi(w[j].y)}; }
        else { const float* src = (r < TLAT) ? (const float*)hlat + (size_t)r * DM : (const float*)hctx + (size_t)(r - TLAT) * DM;
#pragma unroll
            for (int j = 0; j < 8; ++j) v[j] = *(const f32x4*)(src + F.lane * 4 + 256 * j); }
#pragma unroll
        for (int j = 0; j < 8; ++j) ss += (v[j].x * v[j].x + v[j].y * v[j].y) + (v[j].z * v[j].z + v[j].w * v[j].w);
        const float rstd = 1.0f / sqrtf(wave_sum(ss, F.lane) * (1.0f / DM) + 1e-6f);
        bf16* dst = XN + ((size_t)((r >> 8) * (DM / 64) + (F.lane >> 4)) * 256 + (r & 255)) * 64 + (F.lane & 15) * 4;
#pragma unroll
        for (int j = 0; j < 8; ++j) { const f32x4 y = v[j] * rstd * av[j] + sv[j]; v2u o; o.x = pk2(y.x, y.y); o.y = pk2(y.z, y.w); *(v2u*)(dst + (size_t)(4 * j) * 256 * 64) = o; }
    }
}
__device__ __forceinline__ void p_final_norm(const Frame& F, const bf16* h, const float* __restrict__ gain, float* out) {
    const int gw = F.vcu * NWAVES + F.wave, NGW = F.G * NWAVES;
    f32x4 gv[8];
#pragma unroll
    for (int j = 0; j < 8; ++j) gv[j] = *(const f32x4*)(gain + F.lane * 4 + 256 * j);
    for (int r = gw; r < TLAT; r += NGW) { const bf16* p = h + (size_t)r * DM + F.lane * 4; v2u w[8]; f32x4 v[8]; float ss = 0.f;
#pragma unroll
        for (int j = 0; j < 8; ++j) w[j] = *(const v2u*)(p + 256 * j);
#pragma unroll
        for (int j = 0; j < 8; ++j) { v[j] = (f32x4){hlo(w[j].x), hhi(w[j].x), hlo(w[j].y), hhi(w[j].y)}; ss += (v[j].x * v[j].x + v[j].y * v[j].y) + (v[j].z * v[j].z + v[j].w * v[j].w); }
        const float rstd = 1.0f / sqrtf(wave_sum(ss, F.lane) * (1.0f / DM) + 1e-6f);
#pragma unroll
        for (int j = 0; j < 8; ++j) *(f32x4*)(out + (size_t)r * DM + F.lane * 4 + 256 * j) = v[j] * rstd * gv[j]; }
}
__device__ __forceinline__ void p_qkprep(const Frame& F, bf16* Q, bf16* K, const float* __restrict__ qn, const float* __restrict__ kn, int nq_tokens) {
    LAS float* ctab = (LAS float*)F.lds; LAS float* stab = ctab + 2048;
    __syncthreads();
    for (int i = F.tid; i < 2048; i += NTHR) { const int pos = i >> 5, fi = i & 31; const float inv = exp2f(-(float)fi * (13.287712379549449f / 32.0f)); float s, c; sincosf((float)pos * inv, &s, &c); ctab[i] = c; stab[i] = s; }
    __syncthreads();
    const int sub = F.lane & 7, hw = F.lane >> 3;
    const int nqh = nq_tokens * 8, nkh = NB * KVROWS * 2, ngrp = (nqh + nkh) / 8;
    f32x4 gq[4], gk[4];
#pragma unroll
    for (int m = 0; m < 4; ++m) { gq[m] = *(const f32x4*)(qn + sub * 4 + 32 * m); gk[m] = *(const f32x4*)(kn + sub * 4 + 32 * m); }
    const int g0 = F.vcu * NWAVES + F.wave, gstep = F.G * NWAVES;
    v2u wn[4];
    if (g0 < ngrp) { const int hr = g0 * 8 + hw; const bf16* pn_ = (hr < nqh) ? Q + (size_t)hr * 128 : K + (size_t)(hr - nqh) * 128;
#pragma unroll
        for (int m = 0; m < 4; ++m) wn[m] = *(const v2u*)(pn_ + sub * 4 + 32 * m); }
    for (int grp = g0; grp < ngrp; grp += gstep) {
        const int hr = grp * 8 + hw; const bool isq = hr < nqh; bf16* p; int pos;
        if (isq) { const int tok = hr >> 3; p = Q + (size_t)hr * 128; pos = (tok < TLAT) ? (tok & 2047) : -1; }
        else { const int kh = hr - nqh, kvrow = kh >> 1, j = kvrow % KVROWS; p = K + (size_t)kh * 128; pos = (j >= CTXL) ? (j - CTXL) : -1; }
        v2u wc[4];
#pragma unroll
        for (int m = 0; m < 4; ++m) wc[m] = wn[m];
        if (grp + gstep < ngrp) { const int hr2 = (grp + gstep) * 8 + hw; const bf16* pn_ = (hr2 < nqh) ? Q + (size_t)hr2 * 128 : K + (size_t)(hr2 - nqh) * 128;
#pragma unroll
            for (int m = 0; m < 4; ++m) wn[m] = *(const v2u*)(pn_ + sub * 4 + 32 * m); }
        f32x4 x[4]; float ss = 0.f;
#pragma unroll
        for (int m = 0; m < 4; ++m) { const v2u w = wc[m]; x[m] = (f32x4){bflo(w.x), bfhi(w.x), bflo(w.y), bfhi(w.y)}; ss += (x[m].x * x[m].x + x[m].y * x[m].y) + (x[m].z * x[m].z + x[m].w * x[m].w); }
        ss += shx(ss, F.lane, 1); ss += shx(ss, F.lane, 2); ss += shx(ss, F.lane, 4);
        const float rstd = 1.0f / sqrtf(ss * (1.0f / 128.0f) + 1e-6f);
#pragma unroll
        for (int m = 0; m < 4; ++m) x[m] = x[m] * rstd * (isq ? gq[m] : gk[m]);
        if (pos >= 0) { const int pr = pos >> 6, pc = pos & 63;
#pragma unroll
            for (int j = 0; j < 4; ++j) { const int fi = sub * 4 + j;
                const float c0 = ctab[pr * 32 + fi], s0 = stab[pr * 32 + fi], c1 = ctab[pc * 32 + fi], s1 = stab[pc * 32 + fi];
                const float a1 = x[0][j], a2 = x[1][j], b1 = x[2][j], b2 = x[3][j];
                x[0][j] = a1 * c0 - a2 * s0; x[1][j] = a1 * s0 + a2 * c0; x[2][j] = b1 * c1 - b2 * s1; x[3][j] = b1 * s1 + b2 * c1; } }
#pragma unroll
        for (int m = 0; m < 4; ++m) { v2u o; o.x = pk2(x[m].x, x[m].y); o.y = pk2(x[m].z, x[m].w); *(v2u*)(p + sub * 4 + 32 * m) = o; }
    }
    __syncthreads();
}
__device__ __forceinline__ void p_ret_scan(const Frame& F, const unsigned short* __restrict__ KV, bf16* ST, const float* __restrict__ rdec) {
    const int total4 = 64 * 2 * 4096;
    for (int i = F.vcu * NTHR + F.tid; i < total4; i += F.G * NTHR) {
        const int ed = (i & 4095) * 4, dir = (i >> 12) & 1, bh = i >> 13, h = bh & 3;
        const float lg = -expf(rdec[dir * 4 + h]) * 1.4426950408889634f, g256 = exp2f(256.0f * lg);
        const unsigned short* kv = KV + ((size_t)(bh * 9) * 2 + dir) * 16384 + ed; bf16* st = ST + ((size_t)(bh * 8) * 2 + dir) * 16384 + ed;
        f32x4 kvv[9]; v2u kw[9];
#pragma unroll
        for (int b = 0; b < 9; ++b) kw[b] = *(const v2u*)(kv + (size_t)b * 2 * 16384);
#pragma unroll
        for (int b = 0; b < 9; ++b) kvv[b] = (f32x4){hlo(kw[b].x), hhi(kw[b].x), hlo(kw[b].y), hhi(kw[b].y)};
        f32x4 sv = kvv[0];
#pragma unroll
        for (int q = 1; q <= 8; ++q) { const int b = dir ? 9 - q : q;
            const f32x4 o = sv * att::SCALE; v2u w; w.x = pk2(o.x, o.y); w.y = pk2(o.z, o.w); *(v2u*)(st + (size_t)(b - 1) * 2 * 16384) = w;
            const f32x4 kb = dir ? kvv[9 - q] : kvv[q]; sv = sv * g256 + kb; }
    }
}
constexpr int PH_PER_LAYER = 13, N_PHASES = 2 + 2 * PH_PER_LAYER + 1;
struct Args { const float* in[26]; float* out; unsigned char* ws; int ph_lo, ph_hi; };
#ifndef PROBE_MASK
#define PROBE_MASK 0u
#endif
#define NREP(k) ((int)((PROBE_MASK >> (k)) & 1u) + 1)
__global__ void __launch_bounds__(NTHR, 2) mk_fwd(Args args) {
    extern __shared__ __attribute__((aligned(16))) unsigned char lds[];
    Frame F; F.lds = (LAS unsigned char*)lds; F.ldsg = lds;
    F.tid = threadIdx.x; F.lane = F.tid & 63; F.wave = __builtin_amdgcn_readfirstlane(F.tid >> 6);
    F.G = gridDim.x; { const int bx = blockIdx.x; F.vcu = (F.G % 8 == 0) ? (bx % 8) * (F.G / 8) + bx / 8 : bx; }
    unsigned* ctl = (unsigned*)(args.ws + WS_CTL);
    volatile LAS unsigned* MISC = (volatile LAS unsigned*)(F.lds + MISC_OFF);
    for (int u = F.tid; u < (LDS_BYTES - RING_BYTES) / 4; u += NTHR) ((LAS unsigned*)(F.lds + RING_BYTES))[u] = 0u;
    __syncthreads();
    const int lo = args.ph_lo, hi = args.ph_hi;
    XcdBarrier bar; bar.bar = ctl + CW_BAR; bar.x = 0; bar.st = nullptr;
    if (!MK_PER_PHASE) bar = xcd_barrier_post(ctl + CW_BAR, MISC + 8);
    int ph = 0; const int bx = (int)blockIdx.x;
#if MK_PER_PHASE
#define PH_ON (ph >= lo && ph < hi)
#else
#define PH_ON true
#endif
#define PH_FRAME() Frame P = F; { int t_ = threadIdx.x; asm volatile("" : "+v"(t_)); P.tid = t_; P.lane = t_ & 63; P.wave = __builtin_amdgcn_readfirstlane(t_ >> 6); int v_ = F.vcu, g_ = F.G; asm volatile("" : "+s"(v_), "+s"(g_)); P.vcu = v_; P.G = g_; } (void)P; \
    int pbx = (int)blockIdx.x; asm volatile("" : "+s"(pbx)); (void)pbx; \
    int z_ = 0; asm volatile("" : "+s"(z_)); unsigned char* ws = args.ws + z_; unsigned char* R = ws + WS_R; (void)R
#define IN(i) (args.in[(i) + z_])
#define PH_FRAME_Q(Q, widx, nw) Frame Q = F; { int t2_ = threadIdx.x; asm volatile("" : "+v"(t2_)); Q.tid = t2_; Q.lane = t2_ & 63; Q.wave = __builtin_amdgcn_readfirstlane(t2_ >> 6); Q.vcu = (widx); Q.G = (nw); }
#if MK_PER_PHASE
#define PH_END() do { ++ph; asm volatile("" : "+s"(ph)); } while (0)
#else
#define PH_END() do { XcdBarrier b_ = bar; asm volatile("" : "+s"(b_.x)); __attribute__((address_space(1))) unsigned* bp_ = (__attribute__((address_space(1))) unsigned*)b_.bar; asm volatile("" : "+s"(bp_)); b_.bar = (unsigned*)bp_; xcd_barrier(b_); } while (0)
#endif
#define P_HLAT ((bf16*)(args.out + z_))
#define P_HCTX ((bf16*)(ws + WS_HCTX))
#define P_HFIN ((bf16*)(R + 500 * MiB))
#define P_MOD ((float*)(ws + WS_MOD))
#define P_MODL (P_MOD + (size_t)l * 17 * NMODC)
#define P_WB ((bf16*)(ws + WS_W))
#define P_XN ((bf16*)(ws + WS_XN))
#define P_HB ((bf16*)(R + R_H))
#define P_QB ((bf16*)(R + R_Q))
#define P_KB ((bf16*)(R + R_K))
#define P_VB ((bf16*)(R + R_V))
#define P_RB ((bf16*)(R + R_RB))
#define P_PTL ((bf16*)(R + R_PTL))
#define P_PTC ((bf16*)(R + R_PTC))
#define P_GB ((bf16*)(R + R_G))
#define P_YR ((bf16*)(R + R_YR))
#define P_YF ((bf16*)(R + R_YF))
#define P_MODP ((float*)(R + R_MODP))
#define P_NYQP ((float*)(R + R_PTL + 40 * MiB))
#define NORM_CNT(k) ((unsigned*)(ws + WS_CTL) + 16384 + (k) * 144 * 16)
#define P_XBUF ((float*)(ws + 244 * MiB))
#define XL_ ((__attribute__((address_space(3))) unsigned char*)(F.lds + MISC_OFF + 1024))
#define P_KVS ((unsigned short*)(ws + WS_XN + X_KV))
#define P_STS ((bf16*)(ws + WS_XN + X_ST))

    if (PH_ON) for (int rep_ = 0; rep_ < NREP(19); ++rep_) { PH_FRAME();
        p_adaln_partial(P, IN(1), IN(3), IN(4), P_MODP);
        __syncthreads();
        { WSrc S{IN(7), IN(8), IN(9), IN(11), IN(18), IN(15), IN(16), IN(17), IN(20), IN(22), IN(23), IN(24)}; p_convert(P, S, P_WB, 0x003u); }
    }
    PH_END();
    if (PH_ON) for (int rep_ = 0; rep_ < NREP(20); ++rep_) { PH_FRAME(); p_mod_finalize(P, IN(5), P_MODP, P_MOD); }
    PH_END();

    for (int l = 0; l < 2; ++l) {
        const bool l0 = (l == 0);
        const int nMall = l0 ? 144 : 128;
        if (PH_ON) { PH_FRAME();
            if (l0) p_norm<false>(P, IN(0), IN(2), IN(6) + l * DM, P_MODL, 0, 1, TALL, P_XN);
        }
        if (l0) PH_END();
        if (PH_ON) for (int rep_ = 0; rep_ < NREP(1); ++rep_) { PH_FRAME(); pg8::Gemm g{P_XN, P_WB + W_GU1, TALL, 2 * FFN, DM}; pg8::Order2 S; S.rect(144, 44, P.G, pbx); pg8::EpiSwiglu E{P_HB, FFN, rep_ + 1 < NREP(1)};
            pg8::gemm_phase<pg8::EpiSwiglu, pg8::Order2, true, true, true, true>(F.lds, g, S, E);
            if (l0 && pbx >= (6336 % P.G) && (6336 % P.G) > 0) {
                PH_FRAME_Q(Q, pbx - (6336 % P.G), P.G - (6336 % P.G));
                WSrc S2{IN(7), IN(8), IN(9), IN(11), IN(18), IN(15), IN(16), IN(17), IN(20), IN(22), IN(23), IN(24)}; p_convert(Q, S2, P_WB, 0x004u); } }
        PH_END();
        if (PH_ON) for (int rep_ = 0; rep_ < NREP(2); ++rep_) { PH_FRAME(); pg8::Gemm g{P_HB, P_WB + W_D1, TALL, DM, FFN}; pg8::Order2 S; S.rect(144, 8, P.G, pbx); const bool dry = rep_ + 1 < NREP(2);
            (void)dry;
            if (l0) { pg8::EpiResidNorm<true, false> E{IN(0), IN(2), P_HLAT, P_HCTX, P_MODL, 2, 0.5f, IN(10) + l * DM, P_MODL, 3, 4, P_XN, nullptr, P_XBUF, NORM_CNT(l * 3 + 0), XL_}; pg8::gemm_phase<pg8::EpiResidNorm<true, false>, pg8::Order2, true, true, true, true>(F.lds, g, S, E); }
            else { pg8::EpiResidNorm<false, false> E{P_HLAT, P_HCTX, P_HLAT, P_HCTX, P_MODL, 2, 0.5f, IN(10) + l * DM, P_MODL, 3, 4, P_XN, nullptr, P_XBUF, NORM_CNT(l * 3 + 0), XL_}; pg8::gemm_phase<pg8::EpiResidNorm<false, false>, pg8::Order2, true, true, true, true>(F.lds, g, S, E); }
            if (pbx >= (1152 % P.G) && (1152 % P.G) > 0) {
                PH_FRAME_Q(Q, pbx - (1152 % P.G), P.G - (1152 % P.G));
                if (l0) { WSrc S2{IN(7), IN(8), IN(9), IN(11), IN(18), IN(15), IN(16), IN(17), IN(20), IN(22), IN(23), IN(24)}; p_convert(Q, S2, P_WB, 0xFD8u); __syncthreads();
                    p_fold(Q, IN(11), P_WB + W_FOLD); p_wbf_fold(Q, IN(15), P_WB + W_BF); p_consts(Q, (bf16*)(ws + WS_AMAT), (bf16*)(ws + WS_AMATC)); }
                else { const size_t a = (size_t)DM * FFN; WSrc S2{nullptr, nullptr, nullptr, nullptr, nullptr, nullptr, nullptr, nullptr, nullptr, IN(22) + a, IN(23) + a, IN(24) + a}; p_convert(Q, S2, P_WB, 0xE00u); } } }
        PH_END();
        if (PH_ON) { PH_FRAME();
            for (int rep_ = 0; rep_ < NREP(4); ++rep_) { pg8::Gemm g{P_XN, P_WB + W_CAT, TALL, NCAT, DM}; pg8::Order2 S;
              S.init(128, 38, 16, l0 ? 38 : 6, 128, l0 ? 38 : 2, l0 ? 0 : 4, l0 ? 0 : 6, P.G, pbx);
              pg8::EpiMix E{P_QB, P_KB, P_VB, P_RB, P_GB, IN(19) + (size_t)l * 6144};
              pg8::gemm_phase<pg8::EpiMix, pg8::Order2, true, true, true, true>(F.lds, g, S, E); }
            for (int rep_ = 0; rep_ < NREP(5); ++rep_) { pg8::Gemm g{P_WB + W_FOLD, P_XN, 512, TALL, DM}; pg8::Order2 S; S.rect(2, nMall, P.G, (pbx + (P.G >> 1)) % P.G);     pg8::EpiFold E{P_PTL, P_PTC};
              pg8::gemm_phase<pg8::EpiFold, pg8::Order2, true, true, true, true>(F.lds, g, S, E); }
        }
        PH_END();
        if (PH_ON) { PH_FRAME();
            p_qkprep(P, P_QB, P_KB, IN(12) + l * 128, IN(13) + l * 128, 0);
            for (int rep_ = 0; rep_ < NREP(7); ++rep_) for (int n = P.vcu; n < 576; n += P.G) { const int bh = n / 9, blk = n % 9, b = bh >> 2, h = bh & 3;
                const float lgf = -expf(IN(14)[l * 8 + h]) * 1.4426950408889634f, lgb = -expf(IN(14)[l * 8 + 4 + h]) * 1.4426950408889634f;
                const long rowbase = blk ? (long)b * SEQ + (blk - 1) * 256 : (long)TLAT + b * CTXL;
                att::ret_summary_unit(P_RB, P_KVS + (size_t)(bh * 9 + blk) * 2 * 16384, rowbase, h, lgf, lgb, (char*)lds); }
            __syncthreads();
            for (int rep_ = 0; rep_ < NREP(8); ++rep_) {
              { pg8::Gemm g{(bf16*)(ws + WS_AMAT), P_PTL, SEQ, 4096, SEQ}; pg8::Order2 S; S.rect(8, 16, P.G, pbx); pg8::EpiDft E{P_YF, 1.0f / 512.0f, SEQ, 0};
                pg8::gemm_phase<pg8::EpiDft, pg8::Order2, true, true>(F.lds, g, S, E); }
              { pg8::Gemm g{(bf16*)(ws + WS_AMAT) + (size_t)SEQ * SEQ, P_PTL + (size_t)16 * 256 * SEQ, SEQ, 4096, SEQ}; pg8::Order2 S; S.rect(8, 16, P.G, (pbx + (P.G >> 1)) % P.G); pg8::EpiDft E{P_YF, 1.0f / 512.0f, SEQ, 1};
                pg8::gemm_phase<pg8::EpiDft, pg8::Order2, true, true>(F.lds, g, S, E); } }
            if (l0) {
              { pg8::Gemm g{(bf16*)(ws + WS_AMATC), P_PTC, CTXL, 4096, CTXL}; pg8::Order2 S; S.rect(1, 16, P.G, (pbx + (P.G >> 2)) % P.G); pg8::EpiDft E{P_YF + (size_t)TLAT * 512, 0.005524271728019903f, CTXL, 0};
                pg8::gemm_phase<pg8::EpiDft, pg8::Order2, true, true>(F.lds, g, S, E); }
              { pg8::Gemm g{(bf16*)(ws + WS_AMATC) + (size_t)CTXL * CTXL, P_PTC + (size_t)16 * 256 * CTXL, CTXL, 4096, CTXL}; pg8::Order2 S; S.rect(1, 16, P.G, (pbx + 3 * (P.G >> 2)) % P.G); pg8::EpiDft E{P_YF + (size_t)TLAT * 512, 0.005524271728019903f, CTXL, 1};
                pg8::gemm_phase<pg8::EpiDft, pg8::Order2, true, true>(F.lds, g, S, E); } }
        }
        PH_END();
        if (PH_ON) { PH_FRAME();
            for (int rep_ = 0; rep_ < NREP(9); ++rep_) p_ret_scan(P, P_KVS, P_STS, IN(14) + l * 8);
            __syncthreads();
#pragma unroll 1
            for (int ks = 0; ks < 8; ++ks) { pg8::Gemm g{(bf16*)(ws + WS_AMAT) + ks * 256, P_PTL + (size_t)2 * 16 * 256 * SEQ + ks * 256, SEQ, 256, 256, SEQ, SEQ}; pg8::Order2 S; S.rect(8, 1, P.G, (pbx + P.G - 8 * ks) % P.G);
              pg8::EpiNyqP E{P_NYQP + (size_t)ks * SEQ * 64};
              pg8::gemm_phase<pg8::EpiNyqP, pg8::Order2, true, true>(F.lds, g, S, E); }
            if (l0) { pg8::Gemm g{(bf16*)(ws + WS_AMATC), P_PTC + (size_t)2 * 16 * 256 * CTXL, CTXL, 256, CTXL}; pg8::Order2 S; S.rect(1, 1, P.G, (pbx + (P.G >> 2)) % P.G); pg8::EpiNyq E{P_YF + (size_t)TLAT * 512, 0.005524271728019903f, CTXL};
              pg8::gemm_phase<pg8::EpiNyq, pg8::Order2, true, true>(F.lds, g, S, E); }
        }
        PH_END();
        if (PH_ON) { PH_FRAME();
            for (int i = P.vcu * NTHR + P.tid; i < SEQ * 64; i += P.G * NTHR) { const int t = i >> 6, c = i & 63; float sum = 0.f;
#pragma unroll
                for (int ks = 0; ks < 8; ++ks) sum += P_NYQP[(size_t)ks * SEQ * 64 + i];
                P_YF[((size_t)(c >> 2) * SEQ + t) * 512 + (c & 3) * 128 + 64] = (bf16)(pk2(sum * (1.0f / 512.0f), 0.f) & 0xffffu); }
            const int nat = l0 ? 1152 : 1024, nrt = l0 ? 576 : 512;
            const bool rfirst = (P.vcu & 1) != 0;
#pragma unroll 1
            for (int pass = 0; pass < 2; ++pass) {
            if ((pass == 0) != rfirst) {
            for (int rep_ = 0; rep_ < NREP(10); ++rep_) { const bool dry = rep_ + 1 < NREP(10);
            for (int n = P.vcu; n < nat; n += P.G) {
                if (n < 1024) { const int grp = n >> 5, loc = n & 31, b = grp >> 1, kvh = grp & 1, head = kvh * 4 + (loc >> 3), qb = loc & 7;
                    bf16* qp = P_QB + ((size_t)b * SEQ + qb * 256) * 1024 + head * 128;
                    att::attn_dense_body(qp, P_KB + (size_t)b * KVROWS * 256 + kvh * 128, P_VB + (size_t)b * KVROWS * 256 + kvh * 128, dry ? P_PTL : qp, KVROWS, (char*)lds, IN(12) + l * 128, qb * 256); }
                else { const int m = n - 1024, b = m >> 3, head = m & 7, kvh = head >> 2;
                    bf16* qp = P_QB + ((size_t)TLAT + b * CTXL) * 1024 + head * 128;
                    att::attn_dense_body(qp, P_KB + (size_t)b * KVROWS * 256 + kvh * 128, P_VB + (size_t)b * KVROWS * 256 + kvh * 128, dry ? P_PTL : qp, CTXL, (char*)lds, IN(12) + l * 128, -1); }
            } } } else {
            for (int rep_ = 0; rep_ < NREP(11); ++rep_) for (int n = (P.vcu + (P.G >> 1)) % P.G; n < nrt; n += P.G) {
                int bh, blk; if (n < 512) { bh = n >> 3; blk = (n & 7) + 1; } else { bh = n - 512; blk = 0; }
                const int b = bh >> 2, h = bh & 3;
                const float lgf = -expf(IN(14)[l * 8 + h]) * 1.4426950408889634f, lgb = -expf(IN(14)[l * 8 + 4 + h]) * 1.4426950408889634f;
                const long rowbase = blk ? (long)b * SEQ + (blk - 1) * 256 : (long)TLAT + b * CTXL;
                const bf16* sf = blk ? P_STS + ((size_t)(bh * 8 + blk - 1) * 2) * 16384 : nullptr;
                att::ret_output_unit(P_RB, sf, blk ? sf + 16384 : nullptr, P_YR, rowbase, h, lgf, lgb, (char*)lds);
                __syncthreads(); } } }
        }
        PH_END();
        if (PH_ON) { PH_FRAME();
            for (int rep_ = 0; rep_ < NREP(12); ++rep_) { pg8::Gemm g{P_YF, P_WB + W_BF, nMall * 256, DM, 512}; pg8::Order2 S; S.rect(nMall, 8, P.G, pbx); pg8::EpiMerge<true> E{P_XN, P_GB, 0};
                pg8::gemm_phase<pg8::EpiMerge<true>, pg8::Order2, true, true, false, true>(F.lds, g, S, E); }
            asm volatile("s_waitcnt vmcnt(0)" ::: "memory");
            { pg8::Gemm g{P_QB, P_WB + W_BA, nMall * 256, DM, 1024}; pg8::Order2 S; S.rect(nMall, 8, P.G, pbx); pg8::EpiMerge<false> E{P_XN, P_GB, 2048};
                pg8::gemm_phase<pg8::EpiMerge<false>, pg8::Order2, true, true, false, true>(F.lds, g, S, E); }
            asm volatile("s_waitcnt vmcnt(0)" ::: "memory");
            { pg8::Gemm g{P_YR, P_WB + W_BR, nMall * 256, DM, 512}; pg8::Order2 S; S.rect(nMall, 8, P.G, pbx); pg8::EpiMerge<false> E{P_XN, P_GB, 4096};
                pg8::gemm_phase<pg8::EpiMerge<false>, pg8::Order2, true, true, false, true>(F.lds, g, S, E); }
        }
        PH_END();
        if (PH_ON) for (int rep_ = 0; rep_ < NREP(15); ++rep_) { PH_FRAME(); pg8::Gemm g{P_XN, P_WB + W_OUT, nMall * 256, DM, DM}; pg8::Order2 S; S.rect(nMall, 8, P.G, pbx); const bool dry = rep_ + 1 < NREP(15);
            (void)dry;
            pg8::EpiResidNorm<false, false> E{P_HLAT, P_HCTX, l0 ? P_HLAT : P_HFIN, P_HCTX, P_MODL, 5, 1.0f, IN(21) + l * DM, P_MODL, 6, 7, P_XN, nullptr, P_XBUF, NORM_CNT(l * 3 + 1), XL_};
            pg8::gemm_phase<pg8::EpiResidNorm<false, false>, pg8::Order2, true, true, false, true>(F.lds, g, S, E); }
        PH_END();
        if (PH_ON) for (int rep_ = 0; rep_ < NREP(17); ++rep_) { PH_FRAME(); pg8::Gemm g{P_XN, P_WB + W_GU2, nMall * 256, 2 * FFN, DM}; pg8::Order2 S; S.rect(nMall, 44, P.G, pbx); pg8::EpiSwiglu E{P_HB, FFN, rep_ + 1 < NREP(17)};
            pg8::gemm_phase<pg8::EpiSwiglu, pg8::Order2, true, true, true, true>(F.lds, g, S, E); }
        PH_END();
        if (PH_ON) for (int rep_ = 0; rep_ < NREP(18); ++rep_) { PH_FRAME(); pg8::Gemm g{P_HB, P_WB + W_D2, nMall * 256, DM, FFN}; pg8::Order2 S; S.rect(nMall, 8, P.G, pbx); const bool dry = rep_ + 1 < NREP(18);
            (void)dry;
            if (l0) { pg8::EpiResidNorm<false, false> E{P_HLAT, P_HCTX, P_HLAT, P_HCTX, P_MODL, 8, 0.5f, IN(6) + (l + 1) * DM, P_MOD + (size_t)(l + 1) * 17 * NMODC, 0, 1, P_XN, nullptr, P_XBUF, NORM_CNT(l * 3 + 2), XL_};
                pg8::gemm_phase<pg8::EpiResidNorm<false, false>, pg8::Order2, true, true, true, true>(F.lds, g, S, E); }
            else { pg8::EpiResidNorm<false, true> E{P_HFIN, P_HCTX, nullptr, nullptr, P_MODL, 8, 0.5f, IN(25), nullptr, 0, 0, nullptr, args.out + z_, P_XBUF, NORM_CNT(l * 3 + 2), XL_};
                pg8::gemm_phase<pg8::EpiResidNorm<false, true>, pg8::Order2, true, true, true, true>(F.lds, g, S, E); }
            if (l0 && pbx >= (1152 % P.G) && (1152 % P.G) > 0) {
                PH_FRAME_Q(Q, pbx - (1152 % P.G), P.G - (1152 % P.G));
                const size_t a = (size_t)DM * FFN, b = (size_t)DM * 4096, c = (size_t)DM * 6144;
                const size_t d5 = (size_t)512 * DM, d10 = (size_t)1024 * DM, e = (size_t)DM * DM;
                WSrc S2{IN(7) + a, IN(8) + a, IN(9) + a, IN(11) + b, IN(18) + c, IN(15) + d5, IN(16) + d10, IN(17) + d5, IN(20) + e, nullptr, nullptr, nullptr}; p_convert(Q, S2, P_WB, 0x1DFu); __syncthreads();
                p_fold(Q, IN(11) + b, P_WB + W_FOLD); p_wbf_fold(Q, IN(15) + d5, P_WB + W_BF); } }
        if (l0) PH_END();
    }
    (void)ph; (void)lo; (void)hi;
}

extern "C" void kernel_launch(void* const* d_in, const int* in_sizes, int n_in, void* d_out, int out_size, void* d_ws, size_t ws_size, hipStream_t stream) {
    static int grid = 0;
    if (grid == 0) {
        if (n_in != 26 || in_sizes[0] != TLAT * DM || out_size != TLAT * DM || ws_size < WS_END) { fprintf(stderr, "kernel_launch: shape/workspace mismatch (n_in %d, in0 %d, out %d, ws %zu < %zu); nothing launched\n", n_in, n_in > 0 ? in_sizes[0] : -1, out_size, ws_size, (size_t)WS_END); grid = -1; return; }
        int dev = 0, cus = 0, per_cu = 0;
        if (hipGetDevice(&dev) != hipSuccess || hipDeviceGetAttribute(&cus, hipDeviceAttributeMultiprocessorCount, dev) != hipSuccess) { grid = -1; return; }
        if (hipFuncSetAttribute((const void*)mk_fwd, hipFuncAttributeMaxDynamicSharedMemorySize, LDS_BYTES) != hipSuccess) { fprintf(stderr, "kernel_launch: hipFuncSetAttribute failed\n"); grid = -1; return; }
        if (hipOccupancyMaxActiveBlocksPerMultiprocessor(&per_cu, (const void*)mk_fwd, NTHR, LDS_BYTES) != hipSuccess || per_cu < 1) fprintf(stderr, "kernel_launch: note: occupancy query reports %d workgroups per CU\n", per_cu);
        (void)hipGetLastError();
        grid = cus;
    }
    if (grid < 0) return;
    if (hipMemsetAsync((char*)d_ws + WS_CTL, 0, CTL_ZERO_BYTES, stream) != hipSuccess) { fprintf(stderr, "kernel_launch: memset failed\n"); return; }
    Args a{};
    for (int i = 0; i < 26; ++i) a.in[i] = (const float*)d_in[i];
    a.out = (float*)d_out; a.ws = (unsigned char*)d_ws;
#if MK_PER_PHASE
    for (int p = 0; p < N_PHASES; ++p) { a.ph_lo = p; a.ph_hi = p + 1; hipLaunchKernelGGL(mk_fwd, dim3(grid), dim3(NTHR), LDS_BYTES, stream, a); }
#else
    a.ph_lo = 0; a.ph_hi = N_PHASES; hipLaunchKernelGGL(mk_fwd, dim3(grid), dim3(NTHR), LDS_BYTES, stream, a);
#endif
    const hipError_t le = hipPeekAtLastError();
    if (le != hipSuccess) fprintf(stderr, "kernel_launch: launch failed: %s\n", hipGetErrorName(le));
}
```

```cpp
#include <hip/hip_runtime.h>
#include <hip/hip_bf16.h>
#include <cstdio>
#include <cstdint>
#ifndef MK_PER_PHASE
#define MK_PER_PHASE 0
#endif
namespace pg8 {
#define PG8_LAS __attribute__((address_space(3)))
typedef unsigned short bf16_t;
typedef short bf16x8 __attribute__((ext_vector_type(8)));
typedef float f32x4 __attribute__((ext_vector_type(4)));
typedef unsigned u32x4 __attribute__((ext_vector_type(4)));
constexpr int BM = 256, BK = 64, HALF = 128, HTB = HALF * BK * 2  , STAGE_BYTES = 8 * HTB, NXCD = 8, WGM = 8;

__host__ __device__ __forceinline__ int lds_byte(int r, int c) { const int st = (r >> 4) * 2 + (c >> 5), rr = r & 15, cc = c & 31, ob = rr * 64 + cc * 2; return st * 1024 + (ob ^ (((ob >> 9) & 1) << 5)); }
__host__ __device__ __forceinline__ void stage_rc(int b, int& R, int& C) { const int st = b / 1024, sb = b % 1024, swz = sb ^ (((sb >> 9) & 1) << 5); R = (st >> 1) * 16 + swz / 64; C = (st & 1) * 32 + (swz % 64) / 2; }
__host__ __device__ __forceinline__ int perm32(int rho) { const int n = rho >> 4, i = rho & 15; return 8 * (i >> 2) + 4 * n + (i & 3); }

struct Unit { int pm, pn; };
struct Gemm { const bf16_t* A; const bf16_t* Bt; int M, N, K; int lda = 0, ldb = 0; };
__device__ __forceinline__ unsigned cvt_pk_bf16(float lo, float hi) { unsigned r; asm volatile("v_cvt_pk_bf16_f32 %0, %1, %2" : "=v"(r) : "v"(lo), "v"(hi)); return r; }
typedef float f32x2 __attribute__((ext_vector_type(2)));
struct Order2 {
    int nM1, nN1, nM2, nN2, pm2, split, a0, a1, n1, total, G, c;
    __device__ __forceinline__ void init(int nM1_, int nN1_, int nM2_, int nN2_, int pm2_, int split_, int a0_, int a1_, int G_, int c_) {
        nM1 = nM1_; nN1 = nN1_; nM2 = nM2_; nN2 = nN2_; pm2 = pm2_; split = split_; a0 = a0_; a1 = a1_; n1 = nM1 * nN1; total = n1 + nM2 * nN2; G = G_; c = c_; }
    __device__ __forceinline__ void rect(int nM, int nN, int G_, int c_) { init(nM, nN, 0, 1, 0, 0, 0, 0, G_, c_); }
    __device__ __forceinline__ bool next(int i, Unit& u) const {
        const long L = (long)i * G + c; if (L >= total) return false;
        if (nM1 == 144 && nN1 == 8 && nM2 == 0 && G == 256) {
            const int xcd = c & 7, o = c >> 3;
            const int grp = (i < 4) ? xcd * 4 + i : 32 + (xcd >> 1), idx = (i < 4) ? o : (xcd & 1) * 16 + o;
            u.pm = grp * 4 + (idx & 3); u.pn = idx >> 2; return true; }
        int w = (int)L; { const int q = total / NXCD, r = total % NXCD, xcd = w % NXCD, off = w / NXCD; w = (xcd < r ? xcd * (q + 1) : r * (q + 1) + (xcd - r) * q) + off; }
        int nM = nM1, nN = nN1; const bool second = w >= n1; if (second) { w -= n1; nM = nM2; nN = nN2; }
        const int wgm = 4;
        const int nig = wgm * nN, gid = w / nig, fm = gid * wgm, gsz = (nM - fm) < wgm ? (nM - fm) : wgm;
        int pm = fm + ((w % nig) % gsz), pn = (w % nig) / gsz;
        if (second) { pm += pm2; pn = pn < split ? a0 + pn : a1 + pn; }
        u.pm = pm; u.pn = pn; return true;
    }
    __device__ __forceinline__ void a_ready(const Unit&) const {}
    __device__ __forceinline__ void done(const Unit&) const {}
};

__device__ __forceinline__ float fast_sigmoid(float x) { return __builtin_amdgcn_rcpf(1.0f + __builtin_amdgcn_exp2f(-1.4426950408889634f * x)); }
__device__ __forceinline__ u32x4 pack8(const f32x4 v0, const f32x4 v1) { u32x4 w; w.x = cvt_pk_bf16(v0[0], v0[1]); w.y = cvt_pk_bf16(v0[2], v0[3]); w.z = cvt_pk_bf16(v1[0], v1[1]); w.w = cvt_pk_bf16(v1[2], v1[3]); return w; }
__device__ __forceinline__ void unpack8(const u32x4 w, f32x4& v0, f32x4& v1) {
    v0[0] = __uint_as_float(w.x << 16); v0[1] = __uint_as_float(w.x & 0xffff0000u); v0[2] = __uint_as_float(w.y << 16); v0[3] = __uint_as_float(w.y & 0xffff0000u);
    v1[0] = __uint_as_float(w.z << 16); v1[1] = __uint_as_float(w.z & 0xffff0000u); v1[2] = __uint_as_float(w.w << 16); v1[3] = __uint_as_float(w.w & 0xffff0000u); }

typedef _Float16 f16x2 __attribute__((ext_vector_type(2)));
__device__ __forceinline__ unsigned pk_h2(float lo, float hi) { const f16x2 h = {(_Float16)lo, (_Float16)hi}; return __builtin_bit_cast(unsigned, h); }
__device__ __forceinline__ u32x4 pack8h(const f32x4 v0, const f32x4 v1) { u32x4 w; w.x = pk_h2(v0[0], v0[1]); w.y = pk_h2(v0[2], v0[3]); w.z = pk_h2(v1[0], v1[1]); w.w = pk_h2(v1[2], v1[3]); return w; }
typedef _Float16 f16x8 __attribute__((ext_vector_type(8)));
typedef float f32x8 __attribute__((ext_vector_type(8)));
__device__ __forceinline__ void unpack8h(const u32x4 w, f32x4& v0, f32x4& v1) {
    const f32x8 f = __builtin_convertvector(__builtin_bit_cast(f16x8, w), f32x8);
    v0 = (f32x4){f[0], f[1], f[2], f[3]}; v1 = (f32x4){f[4], f[5], f[6], f[7]}; }
constexpr int NLAT_TILES = 128, DM = 2048, NMODC = 18432;

struct EpiSwiglu {
    static constexpr bool PERM = true, AFTER_DRAIN = false;
    bf16_t* H; int ldh; bool dry = false;
    __device__ __forceinline__ void operator()(const f32x4 (&acc)[2][2][4][2], const Unit& u, int wr, int wc, int fr_, int fq) const {
        int fr = fr_; asm volatile("" : "+v"(fr));
#ifdef PROBE_DRYFAST
        if (dry) { float t = 0.f;
#pragma unroll
            for (int ai = 0; ai < 2; ++ai)
#pragma unroll
                for (int bj = 0; bj < 2; ++bj)
#pragma unroll
                    for (int m = 0; m < 4; ++m)
#pragma unroll
                        for (int n = 0; n < 2; ++n) t += (acc[ai][bj][m][n][0] + acc[ai][bj][m][n][1]) + (acc[ai][bj][m][n][2] + acc[ai][bj][m][n][3]);
            if (t == 12345.678f) H[fr] = 0; return; }
#endif
        bf16_t* Hblk = H + ((size_t)(u.pm * (ldh / BK) + 2 * u.pn + (wc >> 1)) * BM + wr * 64 + fr) * BK + (wc & 1) * 32 + 8 * fq;
#pragma unroll
        for (int ai = 0; ai < 2; ++ai)
#pragma unroll
            for (int m = 0; m < 4; ++m) {
                f32x4 v0, v1;
#pragma unroll
                for (int j = 0; j < 4; ++j) { const float g0 = acc[ai][0][m][0][j], g1 = acc[ai][0][m][1][j];
                    v0[j] = g0 * fast_sigmoid(g0) * acc[ai][1][m][0][j]; v1[j] = g1 * fast_sigmoid(g1) * acc[ai][1][m][1][j]; }
                *(u32x4*)(Hblk + (size_t)(ai * HALF + m * 16) * BK) = pack8(v0, v1); }
    }
};
template <bool BASE_F32> struct EpiResidB {
    static constexpr bool PERM = true, AFTER_DRAIN = false;
    const void* base_lat; const void* base_ctx; bf16_t* out_lat; bf16_t* out_ctx; const float* mod; int gi; float s;
    __device__ __forceinline__ void operator()(const f32x4 (&acc)[2][2][4][2], const Unit& u, int wr, int wc, int fr_, int fq_) const {
        int fr = fr_, fq = fq_; asm volatile("" : "+v"(fr), "+v"(fq));
        const bool lat = u.pm < NLAT_TILES; const int rb = lat ? (u.pm >> 3) : 16; const size_t t0 = (size_t)(lat ? u.pm : u.pm - NLAT_TILES) * BM * DM;
        const int col0 = u.pn * BM + wc * 32 + 8 * fq; const float* gp = mod + (size_t)rb * NMODC + gi * DM + col0;
        f32x4 gv[2][2];
#pragma unroll
        for (int bj = 0; bj < 2; ++bj)
#pragma unroll
            for (int n = 0; n < 2; ++n) gv[bj][n] = *(const f32x4*)(gp + bj * HALF + 4 * n) * s;
        const size_t roff = t0 + (size_t)(wr * 64 + fr) * DM + col0;
        bf16_t* out = (lat ? out_lat : out_ctx) + roff;
        if (BASE_F32) {
            const float* base = (const float*)(lat ? base_lat : base_ctx) + roff;
#pragma unroll
            for (int ai = 0; ai < 2; ++ai) {
                f32x4 bs[4][2][2];
#pragma unroll
                for (int m = 0; m < 4; ++m)
#pragma unroll
                    for (int bj = 0; bj < 2; ++bj)
#pragma unroll
                        for (int n = 0; n < 2; ++n) bs[m][bj][n] = *(const f32x4*)(base + (size_t)(ai * HALF + m * 16) * DM + bj * HALF + 4 * n);
#pragma unroll
                for (int m = 0; m < 4; ++m)
#pragma unroll
                    for (int bj = 0; bj < 2; ++bj) *(u32x4*)(out + (size_t)(ai * HALF + m * 16) * DM + bj * HALF) = pack8h(bs[m][bj][0] + gv[bj][0] * acc[ai][bj][m][0], bs[m][bj][1] + gv[bj][1] * acc[ai][bj][m][1]);
                asm volatile("" ::: "memory"); }
        } else {
            const bf16_t* base = (const bf16_t*)(lat ? base_lat : base_ctx) + roff;
#pragma unroll
            for (int ai = 0; ai < 2; ++ai) {
                u32x4 bw[4][2];
#pragma unroll
                for (int m = 0; m < 4; ++m)
#pragma unroll
                    for (int bj = 0; bj < 2; ++bj) bw[m][bj] = *(const u32x4*)(base + (size_t)(ai * HALF + m * 16) * DM + bj * HALF);
#pragma unroll
                for (int m = 0; m < 4; ++m)
#pragma unroll
                    for (int bj = 0; bj < 2; ++bj) { f32x4 b0, b1; unpack8h(bw[m][bj], b0, b1);
                        *(u32x4*)(out + (size_t)(ai * HALF + m * 16) * DM + bj * HALF) = pack8h(b0 + gv[bj][0] * acc[ai][bj][m][0], b1 + gv[bj][1] * acc[ai][bj][m][1]); }
                asm volatile("" ::: "memory"); }
        }
    }
};
template <bool BASE_F32, bool FINAL> struct EpiResidNorm {
    static constexpr bool PERM = true, AFTER_DRAIN = false;
    const void* base_lat; const void* base_ctx; bf16_t* out_lat; bf16_t* out_ctx; const float* mod; int gi; float s;
    const float* gain; const float* nmod; int ish, isc; bf16_t* XN; float* OUTF; float* xbuf; unsigned* cnt; PG8_LAS unsigned char* xl;
    __device__ __forceinline__ void operator()(f32x4 (&acc)[2][2][4][2], const Unit& u, int wr, int wc, int fr_, int fq_) const {
        int fr = fr_, fq = fq_; asm volatile("" : "+v"(fr), "+v"(fq));
        const bool lat = u.pm < NLAT_TILES; const int rb = lat ? (u.pm >> 3) : 16; const size_t t0 = (size_t)(lat ? u.pm : u.pm - NLAT_TILES) * BM * DM;
        const int col0 = u.pn * BM + wc * 32 + 8 * fq; const float* gp = mod + (size_t)rb * NMODC + gi * DM + col0;
        f32x4 gv[2][2];
#pragma unroll
        for (int bj = 0; bj < 2; ++bj)
#pragma unroll
            for (int n = 0; n < 2; ++n) gv[bj][n] = *(const f32x4*)(gp + bj * HALF + 4 * n) * s;
        const size_t roff = t0 + (size_t)(wr * 64 + fr) * DM + col0;
        if (BASE_F32) { const float* base = (const float*)(lat ? base_lat : base_ctx) + roff;
#pragma unroll
            for (int ai = 0; ai < 2; ++ai)
#pragma unroll
                for (int mh = 0; mh < 2; ++mh) { f32x4 bs[2][2][2];
#pragma unroll
                    for (int m = 0; m < 2; ++m)
#pragma unroll
                        for (int bj = 0; bj < 2; ++bj)
#pragma unroll
                            for (int n = 0; n < 2; ++n) bs[m][bj][n] = *(const f32x4*)(base + (size_t)(ai * HALF + (2 * mh + m) * 16) * DM + bj * HALF + 4 * n);
#pragma unroll
                    for (int m = 0; m < 2; ++m)
#pragma unroll
                        for (int bj = 0; bj < 2; ++bj)
#pragma unroll
                            for (int n = 0; n < 2; ++n) acc[ai][bj][2 * mh + m][n] = bs[m][bj][n] + gv[bj][n] * acc[ai][bj][2 * mh + m][n];
                    asm volatile("" : "+v"(acc[ai][0][2 * mh][0]), "+v"(acc[ai][0][2 * mh][1]), "+v"(acc[ai][1][2 * mh][0]), "+v"(acc[ai][1][2 * mh][1]),
                                      "+v"(acc[ai][0][2 * mh + 1][0]), "+v"(acc[ai][0][2 * mh + 1][1]), "+v"(acc[ai][1][2 * mh + 1][0]), "+v"(acc[ai][1][2 * mh + 1][1]) :: "memory"); }
        } else { const bf16_t* base = (const bf16_t*)(lat ? base_lat : base_ctx) + roff;
#pragma unroll
            for (int ai = 0; ai < 2; ++ai) { u32x4 bw[4][2];
#pragma unroll
                for (int m = 0; m < 4; ++m)
#pragma unroll
                    for (int bj = 0; bj < 2; ++bj) bw[m][bj] = *(const u32x4*)(base + (size_t)(ai * HALF + m * 16) * DM + bj * HALF);
#pragma unroll
                for (int m = 0; m < 4; ++m)
#pragma unroll
                    for (int bj = 0; bj < 2; ++bj) { f32x4 b0, b1; unpack8h(bw[m][bj], b0, b1); acc[ai][bj][m][0] = b0 + gv[bj][0] * acc[ai][bj][m][0]; acc[ai][bj][m][1] = b1 + gv[bj][1] * acc[ai][bj][m][1]; }
                asm volatile("" : "+v"(acc[ai][0][0][0]), "+v"(acc[ai][0][0][1]), "+v"(acc[ai][1][0][0]), "+v"(acc[ai][1][0][1]), "+v"(acc[ai][0][1][0]), "+v"(acc[ai][0][1][1]), "+v"(acc[ai][1][1][0]), "+v"(acc[ai][1][1][1]),
                                  "+v"(acc[ai][0][2][0]), "+v"(acc[ai][0][2][1]), "+v"(acc[ai][1][2][0]), "+v"(acc[ai][1][2][1]), "+v"(acc[ai][0][3][0]), "+v"(acc[ai][0][3][1]), "+v"(acc[ai][1][3][0]), "+v"(acc[ai][1][3][1]) :: "memory"); }
        }
        PG8_LAS float* P = (PG8_LAS float*)xl; PG8_LAS float* S = P + 1024;
#pragma unroll
        for (int ai = 0; ai < 2; ++ai)
#pragma unroll
            for (int m = 0; m < 4; ++m) { float q = 0.f;
#pragma unroll
                for (int bj = 0; bj < 2; ++bj)
#pragma unroll
                    for (int n = 0; n < 2; ++n) { const f32x4 x = acc[ai][bj][m][n]; q += (x[0] * x[0] + x[1] * x[1]) + (x[2] * x[2] + x[3] * x[3]); }
                { auto s_ = __builtin_amdgcn_permlane16_swap(__float_as_uint(q), __float_as_uint(q), false, false); q = __uint_as_float(s_[0]) + __uint_as_float(s_[1]); }
                { auto s_ = __builtin_amdgcn_permlane32_swap(__float_as_uint(q), __float_as_uint(q), false, false); q = __uint_as_float(s_[0]) + __uint_as_float(s_[1]); }
                if (fq == 0) P[(ai * HALF + wr * 64 + m * 16 + fr) * 4 + wc] = q; }
        asm volatile("s_waitcnt lgkmcnt(0)" ::: "memory"); __builtin_amdgcn_s_barrier(); asm volatile("" ::: "memory");
        const int wid = wr * 4 + wc, lane = fq * 16 + fr, row = wid * 32 + (lane & 31);
        if (lane < 32) { const float t = (P[row * 4 + 0] + P[row * 4 + 1]) + (P[row * 4 + 2] + P[row * 4 + 3]);
            __hip_atomic_store(xbuf + ((size_t)u.pm * BM + row) * 8 + u.pn, t, __ATOMIC_RELAXED, __HIP_MEMORY_SCOPE_AGENT); }
        asm volatile("s_waitcnt vmcnt(0)" ::: "memory");
        if (lane == 0) __hip_atomic_fetch_add(cnt + 16 * u.pm, 1u, __ATOMIC_RELAXED, __HIP_MEMORY_SCOPE_AGENT);
        if (!FINAL) { bf16_t* out = (lat ? out_lat : out_ctx) + roff;
#pragma unroll
            for (int ai = 0; ai < 2; ++ai)
#pragma unroll
                for (int m = 0; m < 4; ++m)
#pragma unroll
                    for (int bj = 0; bj < 2; ++bj) *(u32x4*)(out + (size_t)(ai * HALF + m * 16) * DM + bj * HALF) = pack8h(acc[ai][bj][m][0], acc[ai][bj][m][1]); }
        f32x4 av[2][2], sv[2][2];
#pragma unroll
        for (int bj = 0; bj < 2; ++bj)
#pragma unroll
            for (int n = 0; n < 2; ++n) { const int col = col0 + bj * HALF + 4 * n; const f32x4 g = *(const f32x4*)(gain + col);
                if (FINAL) { av[bj][n] = g; sv[bj][n] = (f32x4){0.f, 0.f, 0.f, 0.f}; }
                else { const float* mp = nmod + (size_t)rb * NMODC; av[bj][n] = g * (*(const f32x4*)(mp + isc * DM + col) + 1.0f); sv[bj][n] = *(const f32x4*)(mp + ish * DM + col); } }
        if (wid == 0) { if (lane == 0) { unsigned sp = 0u; while (__hip_atomic_load(cnt + 16 * u.pm, __ATOMIC_RELAXED, __HIP_MEMORY_SCOPE_AGENT) < 64u) { __builtin_amdgcn_s_sleep(1); if (++sp > (1u << 17)) break; } } }
        asm volatile("s_waitcnt lgkmcnt(0)" ::: "memory"); __builtin_amdgcn_s_barrier(); asm volatile("" ::: "memory");
        if (lane < 32) { const float* slot = xbuf + ((size_t)u.pm * BM + row) * 8; float t8[8];
#pragma unroll
            for (int t = 0; t < 8; ++t) t8[t] = __hip_atomic_load(slot + t, __ATOMIC_RELAXED, __HIP_MEMORY_SCOPE_AGENT);
            const float tot = ((t8[0] + t8[1]) + (t8[2] + t8[3])) + ((t8[4] + t8[5]) + (t8[6] + t8[7]));
            S[row] = __builtin_amdgcn_rsqf(tot * (1.0f / DM) + 1e-6f); }
        asm volatile("s_waitcnt lgkmcnt(0)" ::: "memory"); __builtin_amdgcn_s_barrier(); asm volatile("" ::: "memory");
#pragma unroll
        for (int ai = 0; ai < 2; ++ai)
#pragma unroll
            for (int m = 0; m < 4; ++m) { const int r = ai * HALF + wr * 64 + m * 16 + fr; const float rs = S[r];
#pragma unroll
                for (int bj = 0; bj < 2; ++bj) { const f32x4 y0 = acc[ai][bj][m][0] * rs * av[bj][0] + sv[bj][0], y1 = acc[ai][bj][m][1] * rs * av[bj][1] + sv[bj][1];
                    if (FINAL) { float* o = OUTF + ((size_t)u.pm * BM + r) * DM + col0 + bj * HALF; *(f32x4*)o = y0; *(f32x4*)(o + 4) = y1; }
                    else *(u32x4*)(XN + (((size_t)u.pm * (DM / BK) + u.pn * 4 + bj * 2 + (wc >> 1)) * BM + r) * BK + (wc & 1) * 32 + 8 * fq) = pack8(y0, y1); } }
    }
};
struct EpiMix {
    static constexpr bool PERM = true, AFTER_DRAIN = false;
    bf16_t *Q, *K, *V, *R, *G; const float* bmg;
    __device__ __forceinline__ void operator()(const f32x4 (&acc)[2][2][4][2], const Unit& u, int wr, int wc, int fr_, int fq) const {
        int fr = fr_; asm volatile("" : "+v"(fr));
        const int pn = u.pn; bf16_t* O; int ld, colt; size_t rowt = (size_t)u.pm * BM; const bool gate = pn >= 14;
        if (pn < 4) { O = Q; ld = 1024; colt = pn * BM; }
        else if (pn < 6) { O = (pn == 4) ? K : V; ld = 256; colt = 0; rowt = (u.pm < NLAT_TILES) ? (size_t)(u.pm >> 3) * 2304 + 256 + (size_t)(u.pm & 7) * BM : (size_t)(u.pm - NLAT_TILES) * 2304; }
        else if (pn < 14) { O = R; ld = 2048; colt = (pn - 6) * BM; }
        else { O = G; ld = 6144; colt = (pn - 14) * BM; }
        const int cl = wc * 32 + 8 * fq;
        f32x4 bv[2][2];
#pragma unroll
        for (int bj = 0; bj < 2; ++bj)
#pragma unroll
            for (int n = 0; n < 2; ++n) bv[bj][n] = *(const f32x4*)(bmg + (gate ? colt : 0) + cl + bj * HALF + 4 * n) * (gate ? 1.0f : 0.0f);
        bf16_t* ob = O + (rowt + wr * 64 + fr) * ld + colt + cl;
#pragma unroll
        for (int ai = 0; ai < 2; ++ai)
#pragma unroll
            for (int m = 0; m < 4; ++m)
#pragma unroll
                for (int bj = 0; bj < 2; ++bj) { f32x4 v0 = acc[ai][bj][m][0], v1 = acc[ai][bj][m][1];
                    v0 += bv[bj][0]; v1 += bv[bj][1];
                    if (gate) {
#pragma unroll
                        for (int j = 0; j < 4; ++j) { v0[j] = fast_sigmoid(v0[j]); v1[j] = fast_sigmoid(v1[j]); } }
                    *(u32x4*)(ob + (size_t)(ai * HALF + m * 16) * ld + bj * HALF) = pack8(v0, v1); }
    }
};
template <int MODE> struct EpiPlain {
    static constexpr bool PERM = true, AFTER_DRAIN = false;
    bf16_t* O0; bf16_t* O1; float scale; int L;
    __device__ __forceinline__ void operator()(const f32x4 (&acc)[2][2][4][2], const Unit& u, int wr, int wc, int fr_, int fq) const {
        int fr = fr_; asm volatile("" : "+v"(fr));
        bf16_t* O; int ld, colt;
        if (MODE == 0) { if (u.pn < NLAT_TILES) { O = O0 + (size_t)(u.pn >> 3) * 1024 * 2048; ld = 2048; colt = (u.pn & 7) * BM; } else { O = O1 + (size_t)(u.pn - NLAT_TILES) * 1024 * 256; ld = 256; colt = 0; } }
        else { O = O0 + (size_t)(u.pn >> 1) * L * 512; ld = 512; colt = (u.pn & 1) * BM; }
        bf16_t* ob = O + (size_t)(u.pm * BM + wr * 64 + fr) * ld + colt + wc * 32 + 8 * fq;
#pragma unroll
        for (int ai = 0; ai < 2; ++ai)
#pragma unroll
            for (int m = 0; m < 4; ++m)
#pragma unroll
                for (int bj = 0; bj < 2; ++bj) *(u32x4*)(ob + (size_t)(ai * HALF + m * 16) * ld + bj * HALF) = pack8(acc[ai][bj][m][0] * scale, acc[ai][bj][m][1] * scale);
    }
};
struct EpiFold {
    static constexpr bool PERM = true, AFTER_DRAIN = false;
    bf16_t* O0; bf16_t* O1;
    __device__ __forceinline__ void operator()(const f32x4 (&acc)[2][2][4][2], const Unit& u, int wr, int wc, int fr_, int fq) const {
        int fr = fr_; asm volatile("" : "+v"(fr));
        const bool lat = u.pn < NLAT_TILES;
        const int b = lat ? (u.pn >> 3) : (u.pn - NLAT_TILES), ld = lat ? 2048 : 256, col0 = (lat ? (u.pn & 7) * BM : 0) + wc * 32 + 8 * fq;
        bf16_t* base = lat ? O0 : O1; const size_t tsz = (size_t)16 * 256 * ld;
        bf16_t* ob = base + (size_t)wr * tsz + (size_t)(b * 256 + u.pm * 128 + fr) * ld + col0;
        bf16_t* on = base + 2 * tsz + (size_t)(b * 4 + u.pm * 2) * ld + col0;
#pragma unroll
        for (int ai = 0; ai < 2; ++ai)
#pragma unroll
            for (int m = 0; m < 4; ++m)
#pragma unroll
                for (int bj = 0; bj < 2; ++bj) { const u32x4 w = pack8(acc[ai][bj][m][0], acc[ai][bj][m][1]);
                    *(u32x4*)(ob + (size_t)(ai * 64 + m * 16) * ld + bj * HALF) = w;
                    if (m == 0) { if (wr == 1 && fr == 0) *(u32x4*)(on + (size_t)ai * ld + bj * HALF) = w; } }
    }
};
struct EpiDft {
    static constexpr bool PERM = true, AFTER_DRAIN = false;
    bf16_t* O0; float scale; int L; int type;
    __device__ __forceinline__ void operator()(const f32x4 (&acc)[2][2][4][2], const Unit& u, int wr, int wc, int fr_, int fq) const {
        int fr = fr_; asm volatile("" : "+v"(fr));
        bf16_t* ob = O0 + ((size_t)u.pn * L + u.pm * BM + wr * 64 + fr) * 512 + (wc >> 1) * 128 + type * 64 + (wc & 1) * 32 + 8 * fq;
#pragma unroll
        for (int ai = 0; ai < 2; ++ai)
#pragma unroll
            for (int m = 0; m < 4; ++m)
#pragma unroll
                for (int bj = 0; bj < 2; ++bj) *(u32x4*)(ob + (size_t)(ai * HALF + m * 16) * 512 + bj * 256) = pack8(acc[ai][bj][m][0] * scale, acc[ai][bj][m][1] * scale);
    }
};
struct EpiNyq {
    static constexpr bool PERM = true, AFTER_DRAIN = false;
    bf16_t* O0; float scale; int L;
    __device__ __forceinline__ void operator()(const f32x4 (&acc)[2][2][4][2], const Unit& u, int wr, int wc, int fr_, int fq) const {
        int fr = fr_; asm volatile("" : "+v"(fr));
        if (wc < 2) { const int c0 = wc * 32 + 8 * fq, b0 = c0 >> 2;
            bf16_t* ob = O0 + ((size_t)b0 * L + u.pm * BM + wr * 64 + fr) * 512 + 64;
#pragma unroll
            for (int ai = 0; ai < 2; ++ai)
#pragma unroll
                for (int m = 0; m < 4; ++m) { const u32x4 w = pack8(acc[ai][0][m][0] * scale, acc[ai][0][m][1] * scale); bf16_t* o = ob + (size_t)(ai * HALF + m * 16) * 512;
                    o[0] = (bf16_t)(w.x & 0xffffu); o[128] = (bf16_t)(w.x >> 16); o[256] = (bf16_t)(w.y & 0xffffu); o[384] = (bf16_t)(w.y >> 16);
                    bf16_t* o2 = o + (size_t)L * 512;
                    o2[0] = (bf16_t)(w.z & 0xffffu); o2[128] = (bf16_t)(w.z >> 16); o2[256] = (bf16_t)(w.w & 0xffffu); o2[384] = (bf16_t)(w.w >> 16); } }
    }
};
struct EpiNyqP {
    static constexpr bool PERM = true, AFTER_DRAIN = false;
    float* Pp;
    __device__ __forceinline__ void operator()(const f32x4 (&acc)[2][2][4][2], const Unit& u, int wr, int wc, int fr_, int fq) const {
        int fr = fr_; asm volatile("" : "+v"(fr));
        if (wc < 2) { float* ob = Pp + (size_t)(u.pm * BM + wr * 64 + fr) * 64 + wc * 32 + 8 * fq;
#pragma unroll
            for (int ai = 0; ai < 2; ++ai)
#pragma unroll
                for (int m = 0; m < 4; ++m) { float* o = ob + (size_t)(ai * HALF + m * 16) * 64; *(f32x4*)o = acc[ai][0][m][0]; *(f32x4*)(o + 4) = acc[ai][0][m][1]; } }
    }
};
template <bool FIRST> struct EpiMerge {
    static constexpr bool PERM = true, AFTER_DRAIN = false;
    bf16_t* Mo; const bf16_t* G; int goff; bf16_t* Mdst = nullptr;
    __device__ __forceinline__ void operator()(const f32x4 (&acc)[2][2][4][2], const Unit& u, int wr, int wc, int fr_, int fq) const {
        int fr = fr_; asm volatile("" : "+v"(fr));
        const size_t row0 = (size_t)u.pm * BM + wr * 64 + fr; const int col0 = u.pn * BM + wc * 32 + 8 * fq;
#pragma unroll
        for (int ai = 0; ai < 2; ++ai) {
            u32x4 gw[4][2], ow[4][2];
#pragma unroll
            for (int m = 0; m < 4; ++m)
#pragma unroll
                for (int bj = 0; bj < 2; ++bj) { const size_t r = row0 + ai * HALF + m * 16; const int c = col0 + bj * HALF;
                    gw[m][bj] = *(const u32x4*)(G + r * 6144 + goff + c); if (!FIRST) ow[m][bj] = *(const u32x4*)(Mo + r * DM + c); }
#pragma unroll
            for (int m = 0; m < 4; ++m)
#pragma unroll
                for (int bj = 0; bj < 2; ++bj) { const size_t r = row0 + ai * HALF + m * 16; const int c = col0 + bj * HALF;
                    f32x4 g0, g1; unpack8(gw[m][bj], g0, g1);
                    f32x4 v0 = g0 * acc[ai][bj][m][0], v1 = g1 * acc[ai][bj][m][1];
                    if (!FIRST) { f32x4 o0, o1; unpack8(ow[m][bj], o0, o1); v0 += o0; v1 += o1; }
                    *(u32x4*)((Mdst ? Mdst : Mo) + r * DM + c) = pack8(v0, v1); }
            asm volatile("" ::: "memory"); }
    }
};
template <class Epi, class Sched, bool ALIGN_EPI = false, bool SP2 = false, bool ABLK = false, bool BBLK = false>
__device__ __forceinline__ void gemm_phase(PG8_LAS unsigned char* lds, const Gemm g, const Sched& S, const Epi& E) {
    int tid_ = threadIdx.x; asm volatile("" : "+v"(tid_));
    const int tid = tid_, wid = __builtin_amdgcn_readfirstlane(tid >> 6), lane = tid & 63, wr = wid >> 2, wc = wid & 3, fr = lane & 15, fq = lane >> 4;
    const int K = g.K, nt = K / BK, LDA = g.lda ? g.lda : K, LDB = g.ldb ? g.ldb : K;
    unsigned voffA[2], voffB[2];
#pragma unroll
    for (int i = 0; i < 2; ++i) { int R, C; stage_rc(tid * 16 + i * 8192, R, C); const int Rb = Epi::PERM ? ((R & ~31) + perm32(R & 31)) : R;
        voffA[i] = ABLK ? (unsigned)(R * BK + C) * 2u : (unsigned)(R * LDA + C) * 2u; voffB[i] = BBLK ? (unsigned)(Rb * BK + C) * 2u : (unsigned)(Rb * LDB + C) * 2u; }
    const size_t kstep = (size_t)(BK * 2);
    const size_t hstepa = (size_t)HALF * LDA * 2, hstepb = (size_t)HALF * LDB * 2;
    const size_t kstepA = ABLK ? (size_t)BM * BK * 2 : kstep, hstepA = ABLK ? (size_t)HALF * BK * 2 : hstepa, tstepA = ABLK ? (size_t)nt * BM * BK * 2 : 2 * hstepa;
    const size_t kstepB = BBLK ? (size_t)BM * BK * 2 : kstep, hstepB = BBLK ? (size_t)HALF * BK * 2 : hstepb, tstepB = BBLK ? (size_t)nt * BM * BK * 2 : 2 * hstepb;
    const unsigned ldsw = (unsigned)wid * 1024u;
    const int aoff = lds_byte(wr * 64 + fr, fq * 8), boff = lds_byte(wc * 32 + fr, fq * 8);
#define PG8_SA(b, h) (((b) * 2 + (h)) * HTB)
#define PG8_SB(b, h) ((4 + (b) * 2 + (h)) * HTB)
#define PG8_STAGE(bufoff, gbase, voff) do { _Pragma("unroll") for (int _i = 0; _i < 2; ++_i) \
        __builtin_amdgcn_global_load_lds((const unsigned*)((const char*)(gbase) + (voff)[_i]), (PG8_LAS unsigned*)(lds + (bufoff) + ldsw + _i * 8192), 16, 0, 0); } while (0)
#define PG8_LDA(dst, b, h) do { _Pragma("unroll") for (int m = 0; m < 4; ++m) _Pragma("unroll") for (int k = 0; k < 2; ++k) dst[m][k] = *(const PG8_LAS bf16x8*)(lds + PG8_SA(b, h) + aoff + m * 2048 + k * 1024); } while (0)
#define PG8_LDB(dst, b, h) do { _Pragma("unroll") for (int n = 0; n < 2; ++n) _Pragma("unroll") for (int k = 0; k < 2; ++k) dst[n][k] = *(const PG8_LAS bf16x8*)(lds + PG8_SB(b, h) + boff + n * 2048 + k * 1024); } while (0)
#define PG8_MMA(ai, bj, At, Bt) do { __builtin_amdgcn_s_setprio(1); _Pragma("unroll") for (int m = 0; m < 4; ++m) _Pragma("unroll") for (int n = 0; n < 2; ++n) _Pragma("unroll") for (int k = 0; k < 2; ++k) \
        acc[ai][bj][m][n] = __builtin_amdgcn_mfma_f32_16x16x32_bf16(Bt[n][k], At[m][k], acc[ai][bj][m][n], 0, 0, 0); __builtin_amdgcn_s_setprio(0); } while (0)
#define PG8_WAIT_V(n) asm volatile("s_waitcnt vmcnt(" #n ")" ::: "memory")
#define PG8_WAIT_L(n) asm volatile("s_waitcnt lgkmcnt(" #n ")" ::: "memory")
#define PG8_BAR __builtin_amdgcn_s_barrier()
#define PG8_SCHED __builtin_amdgcn_sched_barrier(0)
    Unit cur, nxt; int ui = 0;
    if (!S.next(0, cur)) return;
    f32x4 acc[2][2][4][2];
#pragma unroll
    for (int a = 0; a < 2; ++a)
#pragma unroll
        for (int b = 0; b < 2; ++b)
#pragma unroll
            for (int m = 0; m < 4; ++m)
#pragma unroll
                for (int n = 0; n < 2; ++n) acc[a][b][m][n] = (f32x4){0.f, 0.f, 0.f, 0.f};
    bf16x8 At[4][2], B0[2][2], B1[2][2];
    const char* cA = (const char*)g.A + (size_t)cur.pm * tstepA; const char* cB = (const char*)g.Bt + (size_t)cur.pn * tstepB;
    S.a_ready(cur);
    if constexpr (SP2) {
        PG8_STAGE(PG8_SB(0, 0), cB, voffB); PG8_STAGE(PG8_SB(0, 1), cB + hstepB, voffB); PG8_STAGE(PG8_SA(0, 0), cA, voffA); PG8_STAGE(PG8_SA(0, 1), cA + hstepA, voffA);
        if (wr == 1) PG8_BAR;
        PG8_WAIT_V(2); PG8_BAR;
        PG8_STAGE(PG8_SB(1, 0), cB + kstepB, voffB); PG8_STAGE(PG8_SA(1, 0), cA + kstepA, voffA); PG8_STAGE(PG8_SB(1, 1), cB + hstepB + kstepB, voffB);
        PG8_WAIT_V(6); PG8_BAR;
    } else {
        PG8_STAGE(PG8_SB(0, 0), cB, voffB); PG8_STAGE(PG8_SA(0, 0), cA, voffA); PG8_STAGE(PG8_SB(0, 1), cB + hstepB, voffB); PG8_STAGE(PG8_SA(0, 1), cA + hstepA, voffA);
        if (wr == 1) PG8_BAR;
        PG8_WAIT_V(4); PG8_BAR;
        PG8_STAGE(PG8_SB(1, 0), cB + kstepB, voffB); PG8_STAGE(PG8_SA(1, 0), cA + kstepA, voffA); PG8_STAGE(PG8_SB(1, 1), cB + hstepB + kstepB, voffB);
        PG8_WAIT_V(6); PG8_BAR;
    }
    for (;;) {
        const bool has_next = S.next(ui + 1, nxt);
        const char* nA = has_next ? (const char*)g.A + (size_t)nxt.pm * tstepA : cA; const char* nB = has_next ? (const char*)g.Bt + (size_t)nxt.pn * tstepB : cB;
        for (int t = 0; t < nt; t += 2) {
            const bool last = (t == nt - 2);
            const char* a1 = cA + (size_t)(t + 1) * kstepA;
            const char* a2 = last ? nA : cA + (size_t)(t + 2) * kstepA; const char* b2 = last ? nB : cB + (size_t)(t + 2) * kstepB;
            const char* a3 = a2 + kstepA; const char* b3 = b2 + kstepB;
            if (last && has_next) S.a_ready(nxt);
            if constexpr (SP2) {
            PG8_LDB(B0, 0, 0); PG8_LDB(B1, 0, 1); PG8_SCHED; PG8_LDA(At, 0, 0); PG8_STAGE(PG8_SA(1, 1), a1 + hstepA, voffA);
            PG8_WAIT_V(8); PG8_WAIT_L(0); PG8_BAR; PG8_MMA(0, 0, At, B0); PG8_MMA(0, 1, At, B1); PG8_BAR; PG8_SCHED;
            PG8_LDA(At, 0, 1); PG8_STAGE(PG8_SB(0, 0), b2, voffB); PG8_STAGE(PG8_SB(0, 1), b2 + hstepB, voffB); PG8_STAGE(PG8_SA(0, 0), a2, voffA);
            PG8_WAIT_V(8); PG8_WAIT_L(0); PG8_BAR; PG8_MMA(1, 0, At, B0); PG8_MMA(1, 1, At, B1); PG8_BAR; PG8_SCHED;
            PG8_LDB(B0, 1, 0); PG8_LDB(B1, 1, 1); PG8_SCHED; PG8_LDA(At, 1, 0); PG8_STAGE(PG8_SA(0, 1), a2 + hstepA, voffA);
            PG8_WAIT_V(8); PG8_WAIT_L(0); PG8_BAR; PG8_MMA(0, 0, At, B0); PG8_MMA(0, 1, At, B1); PG8_BAR; PG8_SCHED;
            PG8_LDA(At, 1, 1); PG8_STAGE(PG8_SB(1, 0), b3, voffB); PG8_STAGE(PG8_SB(1, 1), b3 + hstepB, voffB); PG8_STAGE(PG8_SA(1, 0), a3, voffA);
            PG8_WAIT_V(8); PG8_WAIT_L(0); PG8_BAR; PG8_MMA(1, 0, At, B0); PG8_MMA(1, 1, At, B1); PG8_BAR; PG8_SCHED;
            } else {
            PG8_LDB(B0, 0, 0); PG8_SCHED; PG8_LDA(At, 0, 0); PG8_STAGE(PG8_SA(1, 1), a1 + hstepA, voffA);
            PG8_WAIT_L(8); PG8_BAR; PG8_WAIT_L(0); PG8_MMA(0, 0, At, B0); PG8_BAR; PG8_SCHED;
            PG8_LDB(B1, 0, 1); PG8_STAGE(PG8_SB(0, 0), b2, voffB);
            PG8_BAR; PG8_WAIT_L(0); PG8_MMA(0, 1, At, B1); PG8_BAR;
            PG8_LDA(At, 0, 1); PG8_STAGE(PG8_SA(0, 0), a2, voffA);
            PG8_BAR; PG8_WAIT_L(0); PG8_MMA(1, 0, At, B0); PG8_BAR; PG8_SCHED;
            PG8_STAGE(PG8_SB(0, 1), b2 + hstepB, voffB);
            PG8_WAIT_V(6); PG8_BAR; PG8_MMA(1, 1, At, B1); PG8_BAR;
            PG8_LDB(B0, 1, 0); PG8_SCHED; PG8_LDA(At, 1, 0); PG8_STAGE(PG8_SA(0, 1), a2 + hstepA, voffA);
            PG8_WAIT_L(8); PG8_BAR; PG8_WAIT_L(0); PG8_MMA(0, 0, At, B0); PG8_BAR; PG8_SCHED;
            PG8_LDB(B1, 1, 1); PG8_STAGE(PG8_SB(1, 0), b3, voffB);
            PG8_BAR; PG8_WAIT_L(0); PG8_MMA(0, 1, At, B1); PG8_BAR;
            PG8_LDA(At, 1, 1); PG8_STAGE(PG8_SA(1, 0), a3, voffA);
            PG8_BAR; PG8_WAIT_L(0); PG8_MMA(1, 0, At, B0); PG8_BAR; PG8_SCHED;
            PG8_STAGE(PG8_SB(1, 1), b3 + hstepB, voffB);
            PG8_WAIT_V(6); PG8_BAR; PG8_MMA(1, 1, At, B1); PG8_BAR;
            }
        }
        if constexpr (ALIGN_EPI) { if (wr == 0) PG8_BAR; }
        if constexpr (!Epi::AFTER_DRAIN) { E(acc, cur, wr, wc, fr, fq); S.done(cur); }
        if (!has_next) break;
#pragma unroll
        for (int a = 0; a < 2; ++a)
#pragma unroll
            for (int b = 0; b < 2; ++b)
#pragma unroll
                for (int m = 0; m < 4; ++m)
#pragma unroll
                    for (int n = 0; n < 2; ++n) acc[a][b][m][n] = (f32x4){0.f, 0.f, 0.f, 0.f};
        cur = nxt; cA = nA; cB = nB; ++ui;
        if constexpr (ALIGN_EPI) { if (wr == 1) PG8_BAR; }
    }
    PG8_WAIT_V(0);
    if constexpr (!ALIGN_EPI) { if (wr == 0) PG8_BAR; }
    PG8_BAR;
    if constexpr (Epi::AFTER_DRAIN) { E.fused(acc, cur, wr, wc, fr, fq, lds, wid, lane); S.done(cur); }
#undef PG8_SA
#undef PG8_SB
#undef PG8_STAGE
#undef PG8_LDA
#undef PG8_LDB
#undef PG8_MMA
#undef PG8_WAIT_V
#undef PG8_WAIT_L
#undef PG8_BAR
#undef PG8_SCHED
}
}
namespace att {
using bf16 = unsigned short;
using bf16x8 = __attribute__((ext_vector_type(8))) short;
using s16x4  = __attribute__((ext_vector_type(4))) short;
using f32x16 = __attribute__((ext_vector_type(16))) float;
using f32x4  = __attribute__((ext_vector_type(4))) float;
using u32x4  = __attribute__((ext_vector_type(4))) unsigned;
using u32x2  = __attribute__((ext_vector_type(2))) unsigned;
constexpr int   D = 128, NW = 8, QBLK = 32, KVBLK = 64;
constexpr float SCALE = 0.088388347648318440f;
constexpr float THR = 8.f;
constexpr int SDEPTH = 2;
constexpr size_t SHM_V = KVBLK * D * 2, SHM_K = KVBLK * D * 2, SHM_ATTN = 2 * SHM_V + 2 * SHM_K + NW * 64 * 4;
#define KSWZ(row, colB) ((row) * 256 + ((colB) ^ (((row) & 7) << 4)))
#define SBAR() __builtin_amdgcn_sched_barrier(0)
__device__ __forceinline__ int crow(int r, int hi) { return (r & 3) + 8 * (r >> 2) + 4 * hi; }
__device__ __forceinline__ unsigned cvtpk(float lo, float hi) { unsigned r; asm volatile("v_cvt_pk_bf16_f32 %0, %1, %2" : "=v"(r) : "v"(lo), "v"(hi)); return r; }
__device__ __forceinline__ bf16x8 ld8(const bf16* p) { return *reinterpret_cast<const bf16x8*>(p); }
__device__ __forceinline__ float bf2f(unsigned short b) { return __uint_as_float(((unsigned)b) << 16); }
__device__ __forceinline__ unsigned short f2bf(float f) { return (unsigned short)(cvtpk(f, 0.f) & 0xffffu); }

__device__ __forceinline__ void partialSM(f32x16& p0, f32x16& p1, float& m_reg, float& mn, float& alpha) {
  constexpr float C = SCALE * 1.4426950408889634f;
  float pmax = p0[0]; for (int r = 1; r < 16; ++r) pmax = fmaxf(pmax, p0[r]); for (int r = 0; r < 16; ++r) pmax = fmaxf(pmax, p1[r]);
  { auto rr = __builtin_amdgcn_permlane32_swap(__float_as_uint(pmax), __float_as_uint(pmax), false, false);
    pmax = fmaxf(__uint_as_float(rr[0]), __uint_as_float(rr[1])); }
  if (__builtin_expect(__all(pmax - m_reg <= THR / SCALE), 1)) { mn = m_reg; alpha = 1.f; }
  else { mn = fmaxf(m_reg, pmax); alpha = __builtin_amdgcn_exp2f((m_reg - mn) * C); m_reg = mn; }
  float mnC = -mn * C;
  for (int r = 0; r < 16; ++r) p0[r] = fmaf(p0[r], C, mnC); for (int r = 0; r < 16; ++r) p1[r] = fmaf(p1[r], C, mnC);
  for (int r = 0; r < 16; ++r) p0[r] = __builtin_amdgcn_exp2f(p0[r]);
}
#define PK4(P, BASE, OUT) do { unsigned a0 = cvtpk(P[BASE + 0], P[BASE + 1]), a1 = cvtpk(P[BASE + 2], P[BASE + 3]);   \
    unsigned b0 = cvtpk(P[BASE + 4], P[BASE + 5]), b1 = cvtpk(P[BASE + 6], P[BASE + 7]);                              \
    auto r0 = __builtin_amdgcn_permlane32_swap(a0, b0, false, false); auto r1 = __builtin_amdgcn_permlane32_swap(a1, b1, false, false); \
    u32x4 w = {r0[0], r1[0], r0[1], r1[1]}; OUT = *reinterpret_cast<bf16x8*>(&w); } while (0)
__device__ __forceinline__ void finishSM(f32x16& p0, f32x16& p1, float alpha, float& l_reg, bf16x8& pa0, bf16x8& pa1, bf16x8& pa2, bf16x8& pa3) {
  for (int r = 0; r < 16; ++r) p1[r] = __builtin_amdgcn_exp2f(p1[r]);
  float ps = 0; for (int r = 0; r < 16; ++r) ps += p0[r]; for (int r = 0; r < 16; ++r) ps += p1[r];
  { auto rr = __builtin_amdgcn_permlane32_swap(__float_as_uint(ps), __float_as_uint(ps), false, false);
    ps = __uint_as_float(rr[0]) + __uint_as_float(rr[1]); }
  l_reg = l_reg * alpha + ps;
  PK4(p0, 0, pa0); PK4(p0, 8, pa1); PK4(p1, 0, pa2); PK4(p1, 8, pa3);
}
__device__ __forceinline__ void qkt(f32x16& p0, f32x16& p1, const bf16* Ks, const bf16x8* qr, int r32, int hi) {
  p0 = f32x16{}; p1 = f32x16{};
  for (int d0 = 0; d0 < 8; ++d0) { int cb = (d0 * 16 + hi * 8) * 2;
    bf16x8 b0 = *reinterpret_cast<const bf16x8*>((const char*)Ks + KSWZ(r32, cb));
    bf16x8 b1 = *reinterpret_cast<const bf16x8*>((const char*)Ks + KSWZ(32 + r32, cb));
    p0 = __builtin_amdgcn_mfma_f32_32x32x16_bf16(b0, qr[d0], p0, 0, 0, 0);
    p1 = __builtin_amdgcn_mfma_f32_32x32x16_bf16(b1, qr[d0], p1, 0, 0, 0); }
}
__device__ __forceinline__ int v_st(int k, int c) { const int kk = (k & ~0xC) | ((k & 4) << 1) | ((k & 8) >> 1); return ((kk >> 3) * 4 + (c >> 5)) * 512 + ((kk & 7) * 32 + (c & 31)) * 2; }
__device__ __forceinline__ int v_rd_base(int lane) { return ((lane & 3) << 3) | (((lane >> 2) & 3) << 6) | (((lane >> 4) & 1) << 5) | (((lane >> 5) & 1) << 8); }
constexpr int v_rd_off(int d0, int ks, int half) { return d0 * 512 + ks * 4096 + half * 2048; }
template <int OFF> __device__ __forceinline__ s16x4 tr_read(int vb) {
  s16x4 r; asm volatile("ds_read_b64_tr_b16 %0, %1 offset:%2" : "=&v"(r) : "v"(vb), "i"(OFF) : "memory"); return r;
}
#define PKLH(L, H) (bf16x8){L[0], L[1], L[2], L[3], H[0], H[1], H[2], H[3]}
template <int D0> __device__ __forceinline__ void pv_one(f32x16& od, int vb, bf16x8 pa0, bf16x8 pa1, bf16x8 pa2, bf16x8 pa3) {
  const s16x4 l0 = tr_read<v_rd_off(D0, 0, 0)>(vb), h0 = tr_read<v_rd_off(D0, 0, 1)>(vb), l1 = tr_read<v_rd_off(D0, 1, 0)>(vb), h1 = tr_read<v_rd_off(D0, 1, 1)>(vb);
  const s16x4 l2 = tr_read<v_rd_off(D0, 2, 0)>(vb), h2 = tr_read<v_rd_off(D0, 2, 1)>(vb), l3 = tr_read<v_rd_off(D0, 3, 0)>(vb), h3 = tr_read<v_rd_off(D0, 3, 1)>(vb);
  asm volatile("s_waitcnt lgkmcnt(0)" ::: "memory"); SBAR();
  od = __builtin_amdgcn_mfma_f32_32x32x16_bf16(pa0, PKLH(l0, h0), od, 0, 0, 0);
  od = __builtin_amdgcn_mfma_f32_32x32x16_bf16(pa1, PKLH(l1, h1), od, 0, 0, 0);
  od = __builtin_amdgcn_mfma_f32_32x32x16_bf16(pa2, PKLH(l2, h2), od, 0, 0, 0);
  od = __builtin_amdgcn_mfma_f32_32x32x16_bf16(pa3, PKLH(l3, h3), od, 0, 0, 0);
}
__device__ __forceinline__ void pv_d0(f32x16* o, int vb, bf16x8 pa0, bf16x8 pa1, bf16x8 pa2, bf16x8 pa3) {
  pv_one<0>(o[0], vb, pa0, pa1, pa2, pa3); pv_one<1>(o[1], vb, pa0, pa1, pa2, pa3); pv_one<2>(o[2], vb, pa0, pa1, pa2, pa3); pv_one<3>(o[3], vb, pa0, pa1, pa2, pa3);
}

constexpr int LDQ = 1024, LDK = 256, LDO = 1024;
__device__ __forceinline__ void attn_dense_body(const bf16* Qb, const bf16* __restrict__ Kh, const bf16* __restrict__ Vh, bf16* Ob, int seq, char* lds, const float* __restrict__ qn, int qpos0) {
  int tid_ = threadIdx.x; asm volatile("" : "+v"(tid_)); const int tid = tid_, wid = tid >> 6, lane = tid & 63, r32 = lane & 31, hi = lane >> 5;
  bf16* V_lds = (bf16*)lds; bf16* K_lds = (bf16*)(lds + 2 * SHM_V);
  float* ws = (float*)(lds + 2 * SHM_V + 2 * SHM_K) + wid * 64; float* li_l = ws; float* al_l = ws + 32;
  float m_reg = -1e30f, l_reg = 0; f32x16 o[4] = {}; bf16x8 qr[8];
  const bf16* Qw = Qb + (long)(wid * QBLK + r32) * LDQ + hi * 8;
#pragma unroll
  for (int d0 = 0; d0 < 8; ++d0) qr[d0] = ld8(Qw + d0 * 16);
  {
    float xf[8][8]; float ss = 0.f;
#pragma unroll
    for (int d0 = 0; d0 < 8; ++d0)
#pragma unroll
      for (int j = 0; j < 8; ++j) { xf[d0][j] = bf2f((unsigned short)qr[d0][j]); ss = fmaf(xf[d0][j], xf[d0][j], ss); }
    ss += __int_as_float(__builtin_amdgcn_ds_bpermute((lane ^ 32) << 2, __float_as_int(ss)));
    const float rstd = 1.0f / sqrtf(ss * (1.0f / 128.0f) + 1e-6f);
#pragma unroll
    for (int d0 = 0; d0 < 8; ++d0) { const f32x4 g0 = *(const f32x4*)(qn + d0 * 16 + hi * 8), g1 = *(const f32x4*)(qn + d0 * 16 + hi * 8 + 4);
#pragma unroll
      for (int j = 0; j < 4; ++j) { xf[d0][j] *= rstd * g0[j]; xf[d0][4 + j] *= rstd * g1[j]; } }
    if (qpos0 >= 0) { const int t = qpos0 + wid * QBLK + r32; const float pr = (float)(t >> 6), pc = (float)(t & 63);
#pragma unroll
      for (int dd = 0; dd < 2; ++dd)
#pragma unroll
        for (int j = 0; j < 8; ++j) { const float inv = exp2f(-(float)(dd * 16 + hi * 8 + j) * (13.287712379549449f / 32.0f));
          const float s0 = __sinf(pr * inv), c0 = __cosf(pr * inv), s1 = __sinf(pc * inv), c1 = __cosf(pc * inv);
          const float a1 = xf[dd][j], a2 = xf[dd + 2][j], b1 = xf[4 + dd][j], b2 = xf[6 + dd][j];
          xf[dd][j] = a1 * c0 - a2 * s0; xf[dd + 2][j] = a1 * s0 + a2 * c0; xf[4 + dd][j] = b1 * c1 - b2 * s1; xf[6 + dd][j] = b1 * s1 + b2 * c1; } }
#pragma unroll
    for (int d0 = 0; d0 < 8; ++d0) { u32x4 w = {cvtpk(xf[d0][0], xf[d0][1]), cvtpk(xf[d0][2], xf[d0][3]), cvtpk(xf[d0][4], xf[d0][5]), cvtpk(xf[d0][6], xf[d0][7])}; qr[d0] = *reinterpret_cast<bf16x8*>(&w); }
  }
  const int sr = tid >> 4, sc = (tid & 15) * 8, vst0 = v_st(sr, sc), vst1 = v_st(32 + sr, sc);
  const int vb0 = (int)(uintptr_t)V_lds + v_rd_base(lane);
  struct { bf16x8 vs0, vs1, ks0, ks1; } sr_[SDEPTH];
#define SLOAD(i, k0) do { sr_[i].vs0 = ld8(&Vh[(long)((k0) + sr) * LDK + sc]); sr_[i].vs1 = ld8(&Vh[(long)((k0) + 32 + sr) * LDK + sc]); \
    sr_[i].ks0 = ld8(&Kh[(long)((k0) + sr) * LDK + sc]); sr_[i].ks1 = ld8(&Kh[(long)((k0) + 32 + sr) * LDK + sc]); } while (0)
#define SWRITE(b, i) do { *(bf16x8*)((char*)V_lds + (b) * SHM_V + vst0) = sr_[i].vs0;          \
    *(bf16x8*)((char*)V_lds + (b) * SHM_V + vst1) = sr_[i].vs1; int kc = sc * 2;               \
    *(bf16x8*)((char*)K_lds + (b) * SHM_K + KSWZ(sr, kc)) = sr_[i].ks0;                       \
    *(bf16x8*)((char*)K_lds + (b) * SHM_K + KSWZ(32 + sr, kc)) = sr_[i].ks1; } while (0)
#define SWAIT() do { asm volatile("s_waitcnt vmcnt(4)" ::: "memory"); } while (0)
#define RESC(a) do { if (__any((a) < 1.f)) { if (hi == 0) al_l[r32] = (a); asm volatile("s_waitcnt lgkmcnt(0)" ::: "memory"); \
    for (int d = 0; d < 4; ++d) for (int r = 0; r < 16; ++r) o[d][r] *= al_l[crow(r, hi)]; } } while (0)
  f32x16 pA0, pA1, pB0, pB1; float mnA, mnB, alA, alB; bf16x8 pa0, pa1, pa2, pa3; const int NT = seq / KVBLK;
  constexpr int SE = 0, SO = SDEPTH - 1;
  SLOAD(SE, 0); asm volatile("s_waitcnt vmcnt(0)" ::: "memory"); SWRITE(0, SE); __syncthreads();
  qkt(pA0, pA1, K_lds, qr, r32, hi); partialSM(pA0, pA1, m_reg, mnA, alA);
  SLOAD(SO, KVBLK); if (2 < NT) SLOAD(SE, 2 * KVBLK);
  SWAIT(); SWRITE(1, SO); __syncthreads();
  for (int j = 1; j + 1 < NT; j += 2) {
    SBAR(); qkt(pB0, pB1, (bf16*)((char*)K_lds + SHM_K), qr, r32, hi);
    finishSM(pA0, pA1, alA, l_reg, pa0, pa1, pa2, pa3); SBAR();
    SLOAD(SO, (j + SDEPTH) * KVBLK); SBAR();
    pv_d0(o, vb0, pa0, pa1, pa2, pa3); partialSM(pB0, pB1, m_reg, mnB, alB);
    __syncthreads(); SWAIT(); SWRITE(0, SE);
    RESC(alB); __syncthreads();
    SBAR(); qkt(pA0, pA1, K_lds, qr, r32, hi);
    finishSM(pB0, pB1, alB, l_reg, pa0, pa1, pa2, pa3); SBAR();
    if (j + 3 < NT) SLOAD(SE, (j + 1 + SDEPTH) * KVBLK); SBAR();
    pv_d0(o, vb0 + (int)SHM_V, pa0, pa1, pa2, pa3); partialSM(pA0, pA1, m_reg, mnA, alA);
    __syncthreads(); SWAIT(); SWRITE(1, SO);
    RESC(alA); __syncthreads();
  }
  SBAR(); qkt(pB0, pB1, (bf16*)((char*)K_lds + SHM_K), qr, r32, hi);
  finishSM(pA0, pA1, alA, l_reg, pa0, pa1, pa2, pa3); SBAR();
  pv_d0(o, vb0, pa0, pa1, pa2, pa3); partialSM(pB0, pB1, m_reg, mnB, alB);
  __syncthreads(); RESC(alB);
  finishSM(pB0, pB1, alB, l_reg, pa0, pa1, pa2, pa3); SBAR();
  pv_d0(o, vb0 + (int)SHM_V, pa0, pa1, pa2, pa3);
  if (hi == 0) li_l[r32] = l_reg; asm volatile("s_waitcnt lgkmcnt(0)" ::: "memory");
  float rli[16];
#pragma unroll
  for (int r = 0; r < 16; ++r) rli[r] = __builtin_amdgcn_rcpf(li_l[crow(r, hi)]);
  bf16* Ow = Ob + (long)(wid * QBLK) * LDO;
#pragma unroll
  for (int r = 0; r < 16; ++r) { int orow = crow(r, hi);
#pragma unroll
    for (int d0 = 0; d0 < 4; ++d0) Ow[(long)orow * LDO + d0 * 32 + r32] = f2bf(o[d0][r] * rli[r]); }
  __syncthreads();
#undef SLOAD
#undef SWRITE
#undef SWAIT
#undef RESC
}

__device__ __forceinline__ void ret_summary_unit(const bf16* __restrict__ Rb, float* KV, long rowbase, int h, float lgf, float lgb, char* lds) {
  int tid_ = threadIdx.x; asm volatile("" : "+v"(tid_)); const int tid = tid_, wid = tid >> 6, lane = tid & 63, r32 = lane & 31, hi = lane >> 5;
  const int dir = wid >> 2, db = wid & 3;
  char* Kim = lds; char* Vf = lds + 16384; char* Vb = lds + 32768;
  const int sr = tid >> 4, sc = (tid & 15) * 8, vst0 = v_st(sr, sc), vst1 = v_st(32 + sr, sc);
  const int vbK = (int)(uintptr_t)Kim + v_rd_base(lane) + db * 512;
  const int vbV = (int)(uintptr_t)(dir ? Vb : Vf) + v_rd_base(lane);
  f32x16 acc[4] = {};
  const bf16* Kp = Rb + rowbase * 2048 + 512 + h * 128 + sc; const bf16* Vp = Rb + rowbase * 2048 + 1024 + h * 128 + sc;
  bf16x8 nk0 = ld8(Kp + (long)sr * 2048), nk1 = ld8(Kp + (long)(sr + 32) * 2048), nv0 = ld8(Vp + (long)sr * 2048), nv1 = ld8(Vp + (long)(sr + 32) * 2048);
  for (int tile = 0; tile < 4; ++tile) {
    const int j0 = tile * 64 + sr, j1 = j0 + 32;
    const bf16x8 k0 = nk0, k1 = nk1, v0 = nv0, v1 = nv1;
    if (tile < 3) { nk0 = ld8(Kp + (long)(j0 + 64) * 2048); nk1 = ld8(Kp + (long)(j1 + 64) * 2048); nv0 = ld8(Vp + (long)(j0 + 64) * 2048); nv1 = ld8(Vp + (long)(j1 + 64) * 2048); }
    const float wf0 = __builtin_amdgcn_exp2f(lgf * (float)(255 - j0)), wf1 = __builtin_amdgcn_exp2f(lgf * (float)(255 - j1));
    const float wb0 = __builtin_amdgcn_exp2f(lgb * (float)j0), wb1 = __builtin_amdgcn_exp2f(lgb * (float)j1);
    u32x4 f0, f1, b0, b1;
#pragma unroll
    for (int q = 0; q < 4; ++q) { const float x0 = bf2f((unsigned short)v0[2 * q]), x1 = bf2f((unsigned short)v0[2 * q + 1]), y0 = bf2f((unsigned short)v1[2 * q]), y1 = bf2f((unsigned short)v1[2 * q + 1]);
      f0[q] = cvtpk(x0 * wf0, x1 * wf0); b0[q] = cvtpk(x0 * wb0, x1 * wb0); f1[q] = cvtpk(y0 * wf1, y1 * wf1); b1[q] = cvtpk(y0 * wb1, y1 * wb1); }
    *(bf16x8*)(Kim + vst0) = k0; *(bf16x8*)(Kim + vst1) = k1;
    *(u32x4*)(Vf + vst0) = f0; *(u32x4*)(Vf + vst1) = f1; *(u32x4*)(Vb + vst0) = b0; *(u32x4*)(Vb + vst1) = b1;
    __syncthreads();
#define RS_STEP(KS) do { const s16x4 al = tr_read<v_rd_off(0, KS, 0)>(vbK), ah = tr_read<v_rd_off(0, KS, 1)>(vbK); \
      const s16x4 l0 = tr_read<v_rd_off(0, KS, 0)>(vbV), h0 = tr_read<v_rd_off(0, KS, 1)>(vbV), l1 = tr_read<v_rd_off(1, KS, 0)>(vbV), h1 = tr_read<v_rd_off(1, KS, 1)>(vbV); \
      const s16x4 l2 = tr_read<v_rd_off(2, KS, 0)>(vbV), h2 = tr_read<v_rd_off(2, KS, 1)>(vbV), l3 = tr_read<v_rd_off(3, KS, 0)>(vbV), h3 = tr_read<v_rd_off(3, KS, 1)>(vbV); \
      asm volatile("s_waitcnt lgkmcnt(0)" ::: "memory"); SBAR(); const bf16x8 af = PKLH(al, ah); \
      acc[0] = __builtin_amdgcn_mfma_f32_32x32x16_bf16(af, PKLH(l0, h0), acc[0], 0, 0, 0); acc[1] = __builtin_amdgcn_mfma_f32_32x32x16_bf16(af, PKLH(l1, h1), acc[1], 0, 0, 0); \
      acc[2] = __builtin_amdgcn_mfma_f32_32x32x16_bf16(af, PKLH(l2, h2), acc[2], 0, 0, 0); acc[3] = __builtin_amdgcn_mfma_f32_32x32x16_bf16(af, PKLH(l3, h3), acc[3], 0, 0, 0); } while (0)
    RS_STEP(0); RS_STEP(1); RS_STEP(2); RS_STEP(3);
#undef RS_STEP
    __syncthreads();
  }
  float* out = KV + (size_t)dir * 16384;
#pragma unroll
  for (int eb = 0; eb < 4; ++eb)
#pragma unroll
    for (int g = 0; g < 4; ++g) { const f32x4 v = {acc[eb][4 * g], acc[eb][4 * g + 1], acc[eb][4 * g + 2], acc[eb][4 * g + 3]};
      *(f32x4*)(out + (size_t)(32 * eb + r32) * 128 + 32 * db + 8 * g + 4 * hi) = v; }
}

template <int CTRL> __device__ __forceinline__ float dppf(float x) { return __builtin_bit_cast(float, __builtin_amdgcn_mov_dpp(__builtin_bit_cast(int, x), CTRL, 0xf, 0xf, true)); }
__device__ __forceinline__ float half32_sum(float x) {
  x += dppf<0xB1>(x); x += dppf<0x4E>(x); x += dppf<0x124>(x); x += dppf<0x128>(x);
  auto s = __builtin_amdgcn_permlane16_swap(__float_as_uint(x), __float_as_uint(x), false, false);
  return __uint_as_float(s[0]) + __uint_as_float(s[1]);
}
__device__ __forceinline__ void ret_output_unit(const bf16* __restrict__ Rb, const bf16* __restrict__ Sf, const bf16* __restrict__ Sb, bf16* Y, long rowbase, int h, float lgf, float lgb, char* lds) {
  int tid_ = threadIdx.x; asm volatile("" : "+v"(tid_)); const int tid = tid_, wid = tid >> 6, lane = tid & 63, r32 = lane & 31, hi = lane >> 5;
  bf16* V_lds = (bf16*)lds; bf16* K_lds = (bf16*)(lds + SHM_V);
  const int a = wid * QBLK + r32;
  f32x16 o[4] = {}; bf16x8 qr[8];
  const bf16* Qw = Rb + (rowbase + a) * 2048 + h * 128 + hi * 8;
#pragma unroll
  for (int d0 = 0; d0 < 8; ++d0) qr[d0] = ld8(Qw + d0 * 16);
  const int sr = tid >> 4, sc = (tid & 15) * 8, vst0 = v_st(sr, sc), vst1 = v_st(32 + sr, sc);
  const int vb0 = (int)(uintptr_t)V_lds + v_rd_base(lane);
  const bf16* Kp = Rb + rowbase * 2048 + 512 + h * 128 + sc; const bf16* Vp = Rb + rowbase * 2048 + 1024 + h * 128 + sc;
  bf16x8 nk0 = ld8(Kp + (long)sr * 2048), nk1 = ld8(Kp + (long)(sr + 32) * 2048), nv0 = ld8(Vp + (long)sr * 2048), nv1 = ld8(Vp + (long)(sr + 32) * 2048);
  if (Sf != nullptr) {
    char* S_lds = lds + 2 * SHM_V;
    { bf16x8 st_[2][4];
#pragma unroll
      for (int dir = 0; dir < 2; ++dir)
#pragma unroll
        for (int i = 0; i < 4; ++i) st_[dir][i] = ld8((dir ? Sb : Sf) + (size_t)(sr + 32 * i) * 128 + sc);
#pragma unroll
      for (int dir = 0; dir < 2; ++dir)
#pragma unroll
        for (int i = 0; i < 4; ++i) *(bf16x8*)(S_lds + dir * 32768 + KSWZ(sr + 32 * i, sc * 2)) = st_[dir][i]; }
    __syncthreads();
    const float sf = __builtin_amdgcn_exp2f(lgf * (float)(a + 1)), sb = __builtin_amdgcn_exp2f(lgb * (float)(256 - a));
#pragma unroll
    for (int dir = 0; dir < 2; ++dir) { const float sc_ = dir ? sb : sf; const char* St = S_lds + dir * 32768;
#pragma unroll
      for (int d0 = 0; d0 < 8; ++d0) { u32x4 w;
#pragma unroll
        for (int q = 0; q < 4; ++q) w[q] = cvtpk(bf2f((unsigned short)qr[d0][2 * q]) * sc_, bf2f((unsigned short)qr[d0][2 * q + 1]) * sc_);
        const bf16x8 qs = *reinterpret_cast<bf16x8*>(&w); const int cb = (d0 * 16 + hi * 8) * 2;
#pragma unroll
        for (int eb = 0; eb < 4; ++eb) o[eb] = __builtin_amdgcn_mfma_f32_32x32x16_bf16(qs, *reinterpret_cast<const bf16x8*>(St + KSWZ(32 * eb + r32, cb)), o[eb], 0, 0, 0); } }
  }
  for (int tile = 0; tile < 4; ++tile) {
    const long j0 = tile * 64 + sr, j1 = j0 + 32;
    const bf16x8 k0 = nk0, k1 = nk1, v0 = nv0, v1 = nv1;
    if (tile < 3) { nk0 = ld8(Kp + (j0 + 64) * 2048); nk1 = ld8(Kp + (j1 + 64) * 2048); nv0 = ld8(Vp + (j0 + 64) * 2048); nv1 = ld8(Vp + (j1 + 64) * 2048); }
    *(bf16x8*)((char*)V_lds + vst0) = v0; *(bf16x8*)((char*)V_lds + vst1) = v1;
    *(bf16x8*)((char*)K_lds + KSWZ(sr, sc * 2)) = k0; *(bf16x8*)((char*)K_lds + KSWZ(32 + sr, sc * 2)) = k1;
    __syncthreads();
    f32x16 p0, p1; qkt(p0, p1, K_lds, qr, r32, hi);
    const int q0 = __builtin_amdgcn_readfirstlane(wid) * QBLK, t0 = tile * 64;
    if (t0 + 63 < q0) {
#pragma unroll
      for (int r = 0; r < 16; ++r) { const int ja = t0 + crow(r, hi); const float da = (float)(a - ja);
        p0[r] *= __builtin_amdgcn_exp2f(lgf * da) * SCALE; p1[r] *= __builtin_amdgcn_exp2f(lgf * (da - 32.f)) * SCALE; }
    } else if (t0 > q0 + 31) {
#pragma unroll
      for (int r = 0; r < 16; ++r) { const int ja = t0 + crow(r, hi); const float da = (float)(ja - a);
        p0[r] *= __builtin_amdgcn_exp2f(lgb * da) * SCALE; p1[r] *= __builtin_amdgcn_exp2f(lgb * (da + 32.f)) * SCALE; }
    } else {
#pragma unroll
    for (int r = 0; r < 16; ++r) {
      const int ja = tile * 64 + crow(r, hi), jb = ja + 32; const float da = (float)(a - ja), db_ = (float)(a - jb);
      const float wa = (da >= 0.f ? __builtin_amdgcn_exp2f(lgf * da) : 0.f) + (da <= 0.f ? __builtin_amdgcn_exp2f(-lgb * da) : 0.f);
      const float wb = (db_ >= 0.f ? __builtin_amdgcn_exp2f(lgf * db_) : 0.f) + (db_ <= 0.f ? __builtin_amdgcn_exp2f(-lgb * db_) : 0.f);
      p0[r] *= wa * SCALE; p1[r] *= wb * SCALE; }
    }
    bf16x8 pa0, pa1, pa2, pa3; PK4(p0, 0, pa0); PK4(p0, 8, pa1); PK4(p1, 0, pa2); PK4(p1, 8, pa3);
    pv_d0(o, vb0, pa0, pa1, pa2, pa3);
    __syncthreads();
  }
  const bf16* Gp = Rb + (rowbase + wid * QBLK) * 2048 + 1536 + h * 128; bf16* Yp = Y + (rowbase + wid * QBLK) * 512 + h * 128;
  unsigned short gq[16][4];
#pragma unroll
  for (int r = 0; r < 16; ++r)
#pragma unroll
    for (int eb = 0; eb < 4; ++eb) gq[r][eb] = Gp[(long)crow(r, hi) * 2048 + 32 * eb + r32];
#pragma unroll
  for (int r = 0; r < 16; ++r) {
    float ss = o[0][r] * o[0][r] + o[1][r] * o[1][r] + o[2][r] * o[2][r] + o[3][r] * o[3][r];
    ss = half32_sum(ss);
    const float rs = __builtin_amdgcn_rsqf(ss * (1.0f / 128.0f) + 1e-6f); const int row = crow(r, hi);
#pragma unroll
    for (int eb = 0; eb < 4; ++eb) { const float g = bf2f(gq[r][eb]);
      const float sg = g * __builtin_amdgcn_rcpf(1.0f + __builtin_amdgcn_exp2f(-1.4426950408889634f * g));
      Yp[(long)row * 512 + 32 * eb + r32] = f2bf(o[eb][r] * rs * sg); } }
}
#undef PK4
#undef PKLH
#undef KSWZ
#undef SBAR
}
constexpr int NWAVES = 8, NTHR = 512;
constexpr int DM = 2048, NB = 16, SEQ = 2048, CTXL = 256, FFN = 5632, NMOD = 9, NMODC = NMOD * DM;
constexpr int TLAT = NB * SEQ, TCTX = NB * CTXL, TALL = TLAT + TCTX;
constexpr int NCAT = 3584 + 6144;
constexpr int KVROWS = SEQ + CTXL;
constexpr size_t MiB = 1u << 20;
constexpr size_t W_GU1 = 0, W_D1 = W_GU1 + (size_t)2 * FFN * DM, W_CAT = W_D1 + (size_t)DM * FFN, W_FOLD = W_CAT + (size_t)NCAT * DM, W_BF = W_FOLD + (size_t)1024 * DM,
                 W_BA = W_BF + (size_t)DM * 512, W_BR = W_BA + (size_t)DM * 1024, W_OUT = W_BR + (size_t)DM * 512, W_GU2 = W_OUT + (size_t)DM * DM, W_D2 = W_GU2 + (size_t)2 * FFN * DM,
                 W_END = W_D2 + (size_t)DM * FFN;
constexpr size_t WS_CTL = 0, CTL_ZERO_BYTES = 1 * MiB;
constexpr size_t WS_MOD = 1 * MiB;
constexpr size_t WS_AMAT = 4 * MiB;
constexpr size_t WS_AMATC = WS_AMAT + 16 * MiB;
constexpr size_t WS_HCTX = 21 * MiB;
constexpr size_t WS_W = 53 * MiB;
constexpr size_t WS_XN = 246 * MiB;
constexpr size_t WS_R = 390 * MiB;
constexpr size_t R_H = 0;
constexpr size_t R_Q = 0;
constexpr size_t R_K = 72 * MiB, R_V = 90 * MiB;
constexpr size_t R_RB = 108 * MiB;
constexpr size_t R_PTL = 252 * MiB, R_PTC = 316 * MiB;
constexpr size_t R_G = 324 * MiB;
constexpr size_t R_YR = 756 * MiB, R_YF = 792 * MiB, R_END = 828 * MiB;
constexpr size_t R_MODP = 0;
constexpr size_t X_KV = 0, X_ST = 76 * MiB;
constexpr size_t WS_END = WS_R + R_END;
static_assert(W_END * 2 <= (WS_XN - WS_W) && WS_MOD + (size_t)2 * 17 * NMODC * 4 <= WS_AMAT && WS_AMATC + 256 * 512 * 2 <= WS_HCTX && WS_HCTX + (size_t)TCTX * DM * 4 <= WS_W, "ws map 1");
static_assert((size_t)TALL * FFN * 2 <= R_END && R_G + (size_t)TALL * 6144 * 2 <= R_YR && X_ST + (size_t)64 * 8 * 2 * 16384 * 2 <= 144 * MiB && (size_t)64 * 9 * 2 * 16384 * 4 <= X_ST, "ws map 2");
constexpr int CW_TMO = 0, CW_BAR = 4096;
constexpr int RING_BYTES = 131072, MISC_OFF = RING_BYTES + 320, LDS_BYTES = 147456;

#define LAS __attribute__((address_space(3)))
typedef unsigned short bf16;
typedef unsigned v4u __attribute__((ext_vector_type(4)));
typedef unsigned v2u __attribute__((ext_vector_type(2)));
typedef float f32x4 __attribute__((ext_vector_type(4)));
__device__ __forceinline__ unsigned pk2(float lo, float hi) { return pg8::cvt_pk_bf16(lo, hi); }
__device__ __forceinline__ float bflo(unsigned w) { return __uint_as_float(w << 16); }
__device__ __forceinline__ float bfhi(unsigned w) { return __uint_as_float(w & 0xffff0000u); }
#define XB_TMO      128
#define XB_XCNT(j)  (256  + 64 * (j))
#define XB_XSUB(j)  (1280 + 64 * (j))
#define XB_XGEN(j)  (2304 + 64 * (j))
#define XB_TOP      3328
#define XB_TOPGEN   3392
#define XCD_BAR_WORDS 3456
#define XB_SPIN_CAP (1u << 18)

__device__ __forceinline__ unsigned xb_ld(unsigned* p)              { return __hip_atomic_load(p, __ATOMIC_RELAXED, __HIP_MEMORY_SCOPE_AGENT); }
__device__ __forceinline__ unsigned xb_add(unsigned* p, unsigned v) { return __hip_atomic_fetch_add(p, v, __ATOMIC_RELAXED, __HIP_MEMORY_SCOPE_AGENT); }
__device__ __forceinline__ unsigned xb_xcc_id() { return (unsigned)__builtin_amdgcn_s_getreg((3 << 11) | 20) & 0xFu; }
#define XB_SPIN(cond, bar) do { unsigned _sp = 0; while (cond) { __builtin_amdgcn_s_sleep(1); \
    if ((++_sp & 255u) == 0u) { if (xb_ld(&(bar)[XB_TMO])) break; if (_sp > XB_SPIN_CAP) { atomicAdd(&(bar)[XB_TMO], 1u); break; } } } } while (0)

struct XcdBarrier {
    unsigned* bar; unsigned x;
    volatile LAS unsigned* st;
};

__device__ __forceinline__ XcdBarrier xcd_barrier_post(unsigned* bar, volatile LAS unsigned* st) {
    XcdBarrier b; b.bar = bar; b.x = xb_xcc_id(); b.st = st;
    if (threadIdx.x == 0) (void)xb_add(&bar[XB_XCNT(b.x)], 1u);
    return b;
}
__device__ __forceinline__ void xcd_barrier_complete(unsigned* bar, unsigned x, unsigned& nloc, unsigned& nx) {
    const unsigned G = gridDim.x * gridDim.y * gridDim.z;
    unsigned sum, cnt, mine, sp = 0u;
    for (;;) {
        sum = 0u; cnt = 0u; mine = 0u;
        unsigned cv[16];
#pragma unroll
        for (unsigned j = 0; j < 16; ++j) cv[j] = xb_ld(&bar[XB_XCNT(j)]);
#pragma unroll
        for (unsigned j = 0; j < 16; ++j) { const unsigned c = cv[j]; sum += c; cnt += (c > 0u) ? 1u : 0u; mine = (j == x) ? c : mine; }
        if (sum == G) break;
        __builtin_amdgcn_s_sleep(1);
        if ((++sp & 255u) == 0u) { if (xb_ld(&bar[XB_TMO])) break; if (sp > XB_SPIN_CAP) { atomicAdd(&bar[XB_TMO], 1u); break; } }
    }
    nloc = mine > 0u ? mine : 1u; nx = cnt > 0u ? cnt : 1u;
}

__device__ __forceinline__ void xcd_barrier(const XcdBarrier& b) {
    asm volatile("s_waitcnt vmcnt(0)" ::: "memory");
    __syncthreads();
    if (threadIdx.x == 0) {
        unsigned* bar = b.bar;
        __builtin_amdgcn_s_waitcnt(0);
        unsigned nloc = b.st[0], nx = b.st[1];
        if (nloc == 0u) { xcd_barrier_complete(bar, b.x, nloc, nx); b.st[0] = nloc; b.st[1] = nx; }
        const unsigned old = xb_add(&bar[XB_XSUB(b.x)], 1u);
        const unsigned gen = old / nloc;
        if (old + 1u == (gen + 1u) * nloc) {
            __builtin_amdgcn_fence(__ATOMIC_RELEASE, "agent");
            asm volatile("s_waitcnt vmcnt(0)" ::: "memory");
            const unsigned og = xb_add(&bar[XB_TOP], 1u);
            const unsigned tg = og / nx;
            if (og + 1u == (tg + 1u) * nx) xb_add(&bar[XB_TOPGEN], 1u);
            else XB_SPIN(xb_ld(&bar[XB_TOPGEN]) == tg, bar);
            __builtin_amdgcn_fence(__ATOMIC_ACQUIRE, "agent");
            xb_add(&bar[XB_XGEN(b.x)], 1u);
            asm volatile("s_waitcnt vmcnt(0)" ::: "memory");
        } else {
            XB_SPIN(xb_ld(&bar[XB_XGEN(b.x)]) == gen, bar);
            __builtin_amdgcn_fence(__ATOMIC_ACQUIRE, "agent");
            asm volatile("s_waitcnt vmcnt(0)" ::: "memory");
        }
    }
    __syncthreads();
}
#define LDS_WAIT() asm volatile("s_waitcnt lgkmcnt(0)" ::: "memory")
__device__ __forceinline__ float hlo(unsigned w) { return (float)__builtin_bit_cast(pg8::f16x2, w)[0]; }
__device__ __forceinline__ float hhi(unsigned w) { return (float)__builtin_bit_cast(pg8::f16x2, w)[1]; }
struct Frame { LAS unsigned char* lds; unsigned char* ldsg; int tid, lane, wave, vcu, G; };
__device__ __forceinline__ float shx(float v, int lane, int o) { return __int_as_float(__builtin_amdgcn_ds_bpermute((lane ^ o) << 2, __float_as_int(v))); }
__device__ __forceinline__ float wave_sum(float v, int lane) {
#pragma unroll
    for (int o = 1; o < 64; o <<= 1) v += shx(v, lane, o);
    return v;
}
__device__ __forceinline__ float silu_f(float x) { return x / (1.0f + __expf(-x)); }

__device__ __forceinline__ void p_adaln_partial(const Frame& F, const float* __restrict__ c, const float* __restrict__ cctx, const float* __restrict__ w_ada, float* modp) {
    LAS float* ca = (LAS float*)(F.lds + F.wave * 10240);
    const int gw = F.vcu * NWAVES + F.wave, NGW = F.G * NWAVES;
    for (int it = gw; it < 2 * 72 * 16; it += NGW) {
        const int ks = it & 15, cb = (it >> 4) % 72, l = it / (72 * 16), k0 = ks * 128;
        for (int i = 0; i < 34; ++i) { const int idx = F.lane + 64 * i, r = idx >> 7, kk = idx & 127;
            const float x = (r < 16) ? c[r * DM + k0 + kk] : cctx[k0 + kk]; ca[kk * 20 + r] = silu_f(x); }
        LDS_WAIT();
        f32x4 acc[17];
#pragma unroll
        for (int r = 0; r < 17; ++r) acc[r] = (f32x4){0.f, 0.f, 0.f, 0.f};
        const float* wp = w_ada + ((size_t)l * DM + k0) * NMODC + cb * 256 + F.lane * 4;
#pragma unroll 4
        for (int kk = 0; kk < 128; ++kk) {
            const f32x4 w = *(const f32x4*)(wp + (size_t)kk * NMODC);
            const LAS f32x4* cp = (const LAS f32x4*)(ca + kk * 20); const f32x4 c0 = cp[0], c1 = cp[1], c2 = cp[2], c3 = cp[3]; const float c16 = ca[kk * 20 + 16];
#pragma unroll
            for (int j = 0; j < 4; ++j) { acc[j] += c0[j] * w; acc[4 + j] += c1[j] * w; acc[8 + j] += c2[j] * w; acc[12 + j] += c3[j] * w; }
            acc[16] += c16 * w; }
        float* op = modp + ((size_t)(l * 16 + ks) * 17) * NMODC + cb * 256 + F.lane * 4;
#pragma unroll
        for (int r = 0; r < 17; ++r) *(f32x4*)(op + (size_t)r * NMODC) = acc[r];
        LDS_WAIT();
    }
}
__device__ __forceinline__ void p_mod_finalize(const Frame& F, const float* __restrict__ b_ada, const float* __restrict__ modp, float* mod) {
    const int n4 = 2 * 17 * (NMODC / 4);
    for (int i = F.vcu * NTHR + F.tid; i < n4; i += F.G * NTHR) { const int l = i / (17 * (NMODC / 4)), rem = i % (17 * (NMODC / 4)), r = rem / (NMODC / 4), c4 = rem % (NMODC / 4);
        f32x4 s = *(const f32x4*)(b_ada + (size_t)l * NMODC + c4 * 4);
        for (int ks = 0; ks < 16; ++ks) s += *(const f32x4*)(modp + ((size_t)(l * 16 + ks) * 17 + r) * NMODC + c4 * 4);
        *(f32x4*)(mod + ((size_t)l * 17 + r) * NMODC + c4 * 4) = s; }
}
__device__ __forceinline__ void cvt_load(f32x4 (&v)[8], const float* __restrict__ W, int ldw, int k0, int n0, int lane) {
    const int r8 = lane >> 3, c4 = lane & 7;
#pragma unroll
    for (int i = 0; i < 8; ++i) v[i] = *(const f32x4*)(W + (size_t)(k0 + 8 * i + r8) * ldw + n0 + 4 * c4);
}
__device__ __forceinline__ void cvt_to_lds(const f32x4 (&v)[8], LAS float* scr, int lane) {
    const int r8 = lane >> 3, c4 = lane & 7;
#pragma unroll
    for (int i = 0; i < 8; ++i)
#pragma unroll
        for (int j = 0; j < 4; ++j) scr[(4 * c4 + j) * 65 + 8 * i + r8] = v[i][j];
}
__device__ __forceinline__ void cvt_store(int K, bf16* WT, int drow0, int k0, LAS float* scr, int lane) {
    const int r8 = lane >> 3, c4 = lane & 7;
#pragma unroll
    for (int jj = 0; jj < 4; ++jj) { const int n = r8 + 8 * jj; const LAS float* s = scr + n * 65 + 8 * c4;
        v4u o; o.x = pk2(s[0], s[1]); o.y = pk2(s[2], s[3]); o.z = pk2(s[4], s[5]); o.w = pk2(s[6], s[7]);
        const int dr = drow0 + n;
        *(v4u*)(WT + ((size_t)((dr >> 8) * (K / 64) + (k0 >> 6)) * 256 + (dr & 255)) * 64 + 8 * c4) = o; }
}
struct WSrc { const float *g1, *u1, *d1, *win, *wmg, *wbf, *wba, *wbr, *wout, *g2, *u2, *d2; };
__device__ __forceinline__ void cvt_decode(int r, const WSrc& S, bf16* Wb, unsigned mask, const float*& W, int& ldw, int& K, bf16*& WT, int& drow0, int& k0, int& n0) {
    bool found = false; W = S.g1; ldw = FFN; K = DM; WT = Wb; drow0 = 0; k0 = 0; n0 = 0;
#define CV_SEG(k, SRC, LDW, KK, NC, DST, MODE) if (!found && ((mask >> (k)) & 1u)) { const int nblk = (NC) / 32, items = ((KK) / 64) * nblk; \
        if (r < items) { found = true; W = (SRC); ldw = (LDW); K = (KK); WT = (DST); const int kb = r / nblk, nb = r % nblk; n0 = nb * 32; k0 = kb * 64; \
            drow0 = ((MODE) == 0) ? n0 : ((n0 >> 7) * 256 + (n0 & 127) + ((MODE) == 2 ? 128 : 0)); } else r -= items; }
    CV_SEG(0, S.g1, FFN, DM, FFN, Wb + W_GU1, 1) CV_SEG(1, S.u1, FFN, DM, FFN, Wb + W_GU1, 2) CV_SEG(2, S.d1, DM, FFN, DM, Wb + W_D1, 0)
    CV_SEG(3, S.win, 4096, DM, 3584, Wb + W_CAT, 0) CV_SEG(4, S.wmg, 6144, DM, 6144, Wb + W_CAT + (size_t)3584 * DM, 0)
    CV_SEG(5, S.wbf, DM, 512, DM, Wb + W_BF, 0) CV_SEG(6, S.wba, DM, 1024, DM, Wb + W_BA, 0) CV_SEG(7, S.wbr, DM, 512, DM, Wb + W_BR, 0) CV_SEG(8, S.wout, DM, DM, DM, Wb + W_OUT, 0)
    CV_SEG(9, S.g2, FFN, DM, FFN, Wb + W_GU2, 1) CV_SEG(10, S.u2, FFN, DM, FFN, Wb + W_GU2, 2) CV_SEG(11, S.d2, DM, FFN, DM, Wb + W_D2, 0)
#undef CV_SEG
}
__device__ __forceinline__ void p_convert(const Frame& F, const WSrc& S, bf16* Wb, unsigned mask) {
    LAS float* scr = (LAS float*)(F.lds + F.wave * 16384);
    const int gw = F.vcu * NWAVES + F.wave, NGW = F.G * NWAVES;
    constexpr int IT_GU = (DM / 64) * (FFN / 32), IT_D = (FFN / 64) * (DM / 32), IT_IN = (DM / 64) * (3584 / 32), IT_MG = (DM / 64) * (6144 / 32), IT_B5 = (512 / 64) * (DM / 32), IT_B10 = (1024 / 64) * (DM / 32), IT_O = (DM / 64) * (DM / 32);
#define ON(k) ((mask >> (k)) & 1u)
    const int NIT = (int)(ON(0) + ON(1) + ON(9) + ON(10)) * IT_GU + (int)(ON(2) + ON(11)) * IT_D + (int)ON(3) * IT_IN + (int)ON(4) * IT_MG + (int)(ON(5) + ON(7)) * IT_B5 + (int)ON(6) * IT_B10 + (int)ON(8) * IT_O;
#undef ON
    if (gw >= NIT) return;
    const float* W; int ldw, K, drow0, k0, n0; bf16* WT; f32x4 v[8];
    cvt_decode(gw, S, Wb, mask, W, ldw, K, WT, drow0, k0, n0); cvt_load(v, W, ldw, k0, n0, F.lane);
    for (int it = gw; it < NIT; it += NGW) {
        cvt_to_lds(v, scr, F.lane);
        const int Kc = K, drc = drow0, k0c = k0; bf16* WTc = WT;
        if (it + NGW < NIT) { cvt_decode(it + NGW, S, Wb, mask, W, ldw, K, WT, drow0, k0, n0); cvt_load(v, W, ldw, k0, n0, F.lane); }
        LDS_WAIT();
        cvt_store(Kc, WTc, drc, k0c, scr, F.lane);
        LDS_WAIT();
    }
}
__device__ __forceinline__ void p_fold(const Frame& F, const float* __restrict__ win, bf16* Wfold) {
    LAS float* wt = (LAS float*)F.lds; LAS float* ct = (LAS float*)(F.lds + 64 * 129 * 4);
    for (int item = F.vcu; item < 128; item += F.G) {
        const int g = item >> 5, k0 = (item & 31) * 64;
        __syncthreads();
        for (int i = 0; i < 16; ++i) { const int idx = F.tid + NTHR * i, kk = idx >> 7, cc = idx & 127; wt[kk * 129 + cc] = win[(size_t)(k0 + kk) * 4096 + 3584 + g * 128 + cc]; }
        if (F.tid < 128) ct[F.tid] = __builtin_amdgcn_cosf((float)F.tid * (1.0f / 128.0f));
        __syncthreads();
        const int fl = F.tid & 127, kk0 = (F.tid >> 7) * 16, ty = fl >> 6, j = fl & 63, kf = (ty && j == 0) ? 64 : j; const bool issin = ty && j;
        float acc[16];
#pragma unroll
        for (int kk = 0; kk < 16; ++kk) acc[kk] = 0.f;
        for (int cc = 0; cc < 128; ++cc) { const int t = (cc * kf) & 127; const float tw = ct[issin ? ((t - 32) & 127) : t];
#pragma unroll
            for (int kk = 0; kk < 16; ++kk) acc[kk] += wt[(kk0 + kk) * 129 + cc] * tw; }
        const int f = g * 128 + fl;
        bf16* op = Wfold + ((size_t)((f >> 8) * (DM / 64) + (k0 >> 6)) * 256 + (f & 255)) * 64 + kk0;
#pragma unroll
        for (int q = 0; q < 2; ++q) { v4u o; o.x = pk2(acc[8 * q], acc[8 * q + 1]); o.y = pk2(acc[8 * q + 2], acc[8 * q + 3]); o.z = pk2(acc[8 * q + 4], acc[8 * q + 5]); o.w = pk2(acc[8 * q + 6], acc[8 * q + 7]); *(v4u*)(op + 8 * q) = o; }
    }
    __syncthreads();
}
__device__ __forceinline__ void p_wbf_fold(const Frame& F, const float* __restrict__ wbf, bf16* WT) {
    for (int i = F.vcu * NTHR + F.tid; i < 2048 * 64; i += F.G * NTHR) { const int n = i & 2047, kb = i >> 11;
        const int g = kb >> 4, ty = (kb >> 3) & 1, j0 = (kb & 7) * 8; float v[8];
#pragma unroll
        for (int e = 0; e < 8; ++e) { const int j = j0 + e; const int r1 = g * 128 + (j == 0 ? (ty ? 64 : 0) : (ty ? 128 - j : j)), r2 = g * 128 + (j == 0 ? 0 : (ty ? j : 128 - j));
            const float a = wbf[(size_t)r1 * DM + n], bq = wbf[(size_t)r2 * DM + n]; v[e] = (j == 0) ? a : (ty ? a - bq : a + bq); }
        v4u o; o.x = pk2(v[0], v[1]); o.y = pk2(v[2], v[3]); o.z = pk2(v[4], v[5]); o.w = pk2(v[6], v[7]);
        *(v4u*)(WT + ((size_t)((n >> 8) * 8 + (kb >> 3)) * 256 + (n & 255)) * 64 + (kb & 7) * 8) = o; }
}
__device__ __forceinline__ void p_consts(const Frame& F, bf16* Amat, bf16* AmatC) {
    LAS float* tab = (LAS float*)F.lds;
    __syncthreads();
    for (int i = F.tid; i < 2048; i += NTHR) tab[i] = __builtin_amdgcn_cosf((float)i * (1.0f / 2048.0f));
    __syncthreads();
    const int h8 = 2048 * 2048 / 8, h8c = 256 * 256 / 8;
    for (int i = F.vcu * NTHR + F.tid; i < 2 * h8 + 2 * h8c; i += F.G * NTHR) {
        float v[8]; bf16* dst;
        if (i < 2 * h8) { const int cs = i >= h8, ii = cs ? i - h8 : i, t = ii >> 8, s0 = (ii & 255) * 8; dst = Amat + (size_t)i * 8;
#pragma unroll
            for (int e = 0; e < 8; ++e) { const int j = (t * (s0 + e)) & 2047; v[e] = cs ? tab[(j - 512) & 2047] : tab[j]; } }
        else { const int i2 = i - 2 * h8, cs = i2 >= h8c, ii = cs ? i2 - h8c : i2, t = ii >> 5, s0 = (ii & 31) * 8; dst = AmatC + (size_t)i2 * 8;
#pragma unroll
            for (int e = 0; e < 8; ++e) { const int j = (8 * t * (s0 + e)) & 2047; v[e] = cs ? tab[(j - 512) & 2047] : tab[j]; } }
        v4u o; o.x = pk2(v[0], v[1]); o.y = pk2(v[2], v[3]); o.z = pk2(v[4], v[5]); o.w = pk2(v[6], v[7]); *(v4u*)dst = o;
    }
    __syncthreads();
}
template <bool SRC16> __device__ __forceinline__ void p_norm(const Frame& F, const void* hlat, const void* hctx, const float* __restrict__ gain, const float* __restrict__ modl, int ish, int isc, int nrows, bf16* XN) {
    const int gw = F.vcu * NWAVES + F.wave, NGW = F.G * NWAVES, chunk = (nrows + NGW - 1) / NGW, r0 = gw * chunk, r1 = (r0 + chunk < nrows) ? r0 + chunk : nrows;
    f32x4 av[8], sv[8]; int cur = -1;
    for (int r = r0; r < r1; ++r) {
        const int rb = (r < TLAT) ? (r >> 11) : 16;
        if (rb != cur) { cur = rb; const float* mp = modl + (size_t)rb * NMODC;
#pragma unroll
            for (int j = 0; j < 8; ++j) { const int col = F.lane * 4 + 256 * j; const f32x4 g = *(const f32x4*)(gain + col), sc = *(const f32x4*)(mp + isc * DM + col); av[j] = g * (sc + 1.0f); sv[j] = *(const f32x4*)(mp + ish * DM + col); } }
        f32x4 v[8]; float ss = 0.f;
        if (SRC16) { const bf16* src = (r < TLAT) ? (const bf16*)hlat + (size_t)r * DM : (const bf16*)hctx + (size_t)(r - TLAT) * DM;
            v2u w[8];
#pragma unroll
            for (int j = 0; j < 8; ++j) w[j] = *(const v2u*)(src + F.lane * 4 + 256 * j);
#pragma unroll
            for (int j = 0; j < 8; ++j) v[j] = (f32x4){hlo(w[j].x), hhi(w[j].x), hlo(w[j].y), hhi(w[j].y)}; }
        else { const float* src = (r < TLAT) ? (const float*)hlat + (size_t)r * DM : (const float*)hctx + (size_t)(r - TLAT) * DM;
#pragma unroll
            for (int j = 0; j < 8; ++j) v[j] = *(const f32x4*)(src + F.lane * 4 + 256 * j); }
#pragma unroll
        for (int j = 0; j < 8; ++j) ss += (v[j].x * v[j].x + v[j].y * v[j].y) + (v[j].z * v[j].z + v[j].w * v[j].w);
        const float rstd = 1.0f / sqrtf(wave_sum(ss, F.lane) * (1.0f / DM) + 1e-6f);
        bf16* dst = XN + ((size_t)((r >> 8) * (DM / 64) + (F.lane >> 4)) * 256 + (r & 255)) * 64 + (F.lane & 15) * 4;
#pragma unroll
        for (int j = 0; j < 8; ++j) { const f32x4 y = v[j] * rstd * av[j] + sv[j]; v2u o; o.x = pk2(y.x, y.y); o.y = pk2(y.z, y.w); *(v2u*)(dst + (size_t)(4 * j) * 256 * 64) = o; }
    }
}
__device__ __forceinline__ void p_final_norm(const Frame& F, const bf16* h, const float* __restrict__ gain, float* out) {
    const int gw = F.vcu * NWAVES + F.wave, NGW = F.G * NWAVES;
    f32x4 gv[8];
#pragma unroll
    for (int j = 0; j < 8; ++j) gv[j] = *(const f32x4*)(gain + F.lane * 4 + 256 * j);
    for (int r = gw; r < TLAT; r += NGW) { const bf16* p = h + (size_t)r * DM + F.lane * 4; v2u w[8]; f32x4 v[8]; float ss = 0.f;
#pragma unroll
        for (int j = 0; j < 8; ++j) w[j] = *(const v2u*)(p + 256 * j);
#pragma unroll
        for (int j = 0; j < 8; ++j) { v[j] = (f32x4){hlo(w[j].x), hhi(w[j].x), hlo(w[j].y), hhi(w[j].y)}; ss += (v[j].x * v[j].x + v[j].y * v[j].y) + (v[j].z * v[j].z + v[j].w * v[j].w); }
        const float rstd = 1.0f / sqrtf(wave_sum(ss, F.lane) * (1.0f / DM) + 1e-6f);
#pragma unroll
        for (int j = 0; j < 8; ++j) *(f32x4*)(out + (size_t)r * DM + F.lane * 4 + 256 * j) = v[j] * rstd * gv[j]; }
}
__device__ __forceinline__ void p_qkprep(const Frame& F, bf16* Q, bf16* K, const float* __restrict__ qn, const float* __restrict__ kn, int nq_tokens) {
    LAS float* ctab = (LAS float*)F.lds; LAS float* stab = ctab + 2048;
    __syncthreads();
    for (int i = F.tid; i < 2048; i += NTHR) { const int pos = i >> 5, fi = i & 31; const float inv = exp2f(-(float)fi * (13.287712379549449f / 32.0f)); float s, c; sincosf((float)pos * inv, &s, &c); ctab[i] = c; stab[i] = s; }
    __syncthreads();
    const int sub = F.lane & 7, hw = F.lane >> 3;
    const int nqh = nq_tokens * 8, nkh = NB * KVROWS * 2, ngrp = (nqh + nkh) / 8;
    f32x4 gq[4], gk[4];
#pragma unroll
    for (int m = 0; m < 4; ++m) { gq[m] = *(const f32x4*)(qn + sub * 4 + 32 * m); gk[m] = *(const f32x4*)(kn + sub * 4 + 32 * m); }
    const int g0 = F.vcu * NWAVES + F.wave, gstep = F.G * NWAVES;
    v2u wn[4];
    if (g0 < ngrp) { const int hr = g0 * 8 + hw; const bf16* pn_ = (hr < nqh) ? Q + (size_t)hr * 128 : K + (size_t)(hr - nqh) * 128;
#pragma unroll
        for (int m = 0; m < 4; ++m) wn[m] = *(const v2u*)(pn_ + sub * 4 + 32 * m); }
    for (int grp = g0; grp < ngrp; grp += gstep) {
        const int hr = grp * 8 + hw; const bool isq = hr < nqh; bf16* p; int pos;
        if (isq) { const int tok = hr >> 3; p = Q + (size_t)hr * 128; pos = (tok < TLAT) ? (tok & 2047) : -1; }
        else { const int kh = hr - nqh, kvrow = kh >> 1, j = kvrow % KVROWS; p = K + (size_t)kh * 128; pos = (j >= CTXL) ? (j - CTXL) : -1; }
        v2u wc[4];
#pragma unroll
        for (int m = 0; m < 4; ++m) wc[m] = wn[m];
        if (grp + gstep < ngrp) { const int hr2 = (grp + gstep) * 8 + hw; const bf16* pn_ = (hr2 < nqh) ? Q + (size_t)hr2 * 128 : K + (size_t)(hr2 - nqh) * 128;
#pragma unroll
            for (int m = 0; m < 4; ++m) wn[m] = *(const v2u*)(pn_ + sub * 4 + 32 * m); }
        f32x4 x[4]; float ss = 0.f;
#pragma unroll
        for (int m = 0; m < 4; ++m) { const v2u w = wc[m]; x[m] = (f32x4){bflo(w.x), bfhi(w.x), bflo(w.y), bfhi(w.y)}; ss += (x[m].x * x[m].x + x[m].y * x[m].y) + (x[m].z * x[m].z + x[m].w * x[m].w); }
        ss += shx(ss, F.lane, 1); ss += shx(ss, F.lane, 2); ss += shx(ss, F.lane, 4);
        const float rstd = 1.0f / sqrtf(ss * (1.0f / 128.0f) + 1e-6f);
#pragma unroll
        for (int m = 0; m < 4; ++m) x[m] = x[m] * rstd * (isq ? gq[m] : gk[m]);
        if (pos >= 0) { const int pr = pos >> 6, pc = pos & 63;
#pragma unroll
            for (int j = 0; j < 4; ++j) { const int fi = sub * 4 + j;
                const float c0 = ctab[pr * 32 + fi], s0 = stab[pr * 32 + fi], c1 = ctab[pc * 32 + fi], s1 = stab[pc * 32 + fi];
                const float a1 = x[0][j], a2 = x[1][j], b1 = x[2][j], b2 = x[3][j];
                x[0][j] = a1 * c0 - a2 * s0; x[1][j] = a1 * s0 + a2 * c0; x[2][j] = b1 * c1 - b2 * s1; x[3][j] = b1 * s1 + b2 * c1; } }
#pragma unroll
        for (int m = 0; m < 4; ++m) { v2u o; o.x = pk2(x[m].x, x[m].y); o.y = pk2(x[m].z, x[m].w); *(v2u*)(p + sub * 4 + 32 * m) = o; }
    }
    __syncthreads();
}
__device__ __forceinline__ void p_ret_scan(const Frame& F, const float* __restrict__ KV, bf16* ST, const float* __restrict__ rdec) {
    const int total4 = 64 * 2 * 4096;
    for (int i = F.vcu * NTHR + F.tid; i < total4; i += F.G * NTHR) {
        const int ed = (i & 4095) * 4, dir = (i >> 12) & 1, bh = i >> 13, h = bh & 3;
        const float lg = -expf(rdec[dir * 4 + h]) * 1.4426950408889634f, g256 = exp2f(256.0f * lg);
        const float* kv = KV + ((size_t)(bh * 9) * 2 + dir) * 16384 + ed; bf16* st = ST + ((size_t)(bh * 8) * 2 + dir) * 16384 + ed;
        f32x4 kvv[9];
#pragma unroll
        for (int b = 0; b < 9; ++b) kvv[b] = *(const f32x4*)(kv + (size_t)b * 2 * 16384);
        f32x4 sv = kvv[0];
#pragma unroll
        for (int q = 1; q <= 8; ++q) { const int b = dir ? 9 - q : q;
            const f32x4 o = sv * att::SCALE; v2u w; w.x = pk2(o.x, o.y); w.y = pk2(o.z, o.w); *(v2u*)(st + (size_t)(b - 1) * 2 * 16384) = w;
            const f32x4 kb = dir ? kvv[9 - q] : kvv[q]; sv = sv * g256 + kb; }
    }
}
constexpr int PH_PER_LAYER = 13, N_PHASES = 2 + 2 * PH_PER_LAYER + 1;
struct Args { const float* in[26]; float* out; unsigned char* ws; int ph_lo, ph_hi; };
#ifndef PROBE_MASK
#define PROBE_MASK 0u
#endif
#define NREP(k) ((int)((PROBE_MASK >> (k)) & 1u) + 1)
__global__ void __launch_bounds__(NTHR, 2) mk_fwd(Args args) {
    extern __shared__ __attribute__((aligned(16))) unsigned char lds[];
    Frame F; F.lds = (LAS unsigned char*)lds; F.ldsg = lds;
    F.tid = threadIdx.x; F.lane = F.tid & 63; F.wave = __builtin_amdgcn_readfirstlane(F.tid >> 6);
    F.G = gridDim.x; { const int bx = blockIdx.x; F.vcu = (F.G % 8 == 0) ? (bx % 8) * (F.G / 8) + bx / 8 : bx; }
    unsigned* ctl = (unsigned*)(args.ws + WS_CTL);
    volatile LAS unsigned* MISC = (volatile LAS unsigned*)(F.lds + MISC_OFF);
    for (int u = F.tid; u < (LDS_BYTES - RING_BYTES) / 4; u += NTHR) ((LAS unsigned*)(F.lds + RING_BYTES))[u] = 0u;
    __syncthreads();
    const int lo = args.ph_lo, hi = args.ph_hi;
    XcdBarrier bar; bar.bar = ctl + CW_BAR; bar.x = 0; bar.st = nullptr;
    if (!MK_PER_PHASE) bar = xcd_barrier_post(ctl + CW_BAR, MISC + 8);
    int ph = 0; const int bx = (int)blockIdx.x;
#if MK_PER_PHASE
#define PH_ON (ph >= lo && ph < hi)
#else
#define PH_ON true
#endif
#define PH_FRAME() Frame P = F; { int t_ = threadIdx.x; asm volatile("" : "+v"(t_)); P.tid = t_; P.lane = t_ & 63; P.wave = __builtin_amdgcn_readfirstlane(t_ >> 6); int v_ = F.vcu, g_ = F.G; asm volatile("" : "+s"(v_), "+s"(g_)); P.vcu = v_; P.G = g_; } (void)P; \
    int pbx = (int)blockIdx.x; asm volatile("" : "+s"(pbx)); (void)pbx; \
    int z_ = 0; asm volatile("" : "+s"(z_)); unsigned char* ws = args.ws + z_; unsigned char* R = ws + WS_R; (void)R
#define IN(i) (args.in[(i) + z_])
#define PH_FRAME_Q(Q, widx, nw) Frame Q = F; { int t2_ = threadIdx.x; asm volatile("" : "+v"(t2_)); Q.tid = t2_; Q.lane = t2_ & 63; Q.wave = __builtin_amdgcn_readfirstlane(t2_ >> 6); Q.vcu = (widx); Q.G = (nw); }
#if MK_PER_PHASE
#define PH_END() do { ++ph; asm volatile("" : "+s"(ph)); } while (0)
#else
#define PH_END() do { XcdBarrier b_ = bar; asm volatile("" : "+s"(b_.x)); __attribute__((address_space(1))) unsigned* bp_ = (__attribute__((address_space(1))) unsigned*)b_.bar; asm volatile("" : "+s"(bp_)); b_.bar = (unsigned*)bp_; xcd_barrier(b_); } while (0)
#endif
#define P_HLAT ((bf16*)(args.out + z_))
#define P_HCTX ((bf16*)(ws + WS_HCTX))
#define P_HFIN ((bf16*)(R + 500 * MiB))
#define P_MOD ((float*)(ws + WS_MOD))
#define P_MODL (P_MOD + (size_t)l * 17 * NMODC)
#define P_WB ((bf16*)(ws + WS_W))
#define P_XN ((bf16*)(ws + WS_XN))
#define P_HB ((bf16*)(R + R_H))
#define P_QB ((bf16*)(R + R_Q))
#define P_KB ((bf16*)(R + R_K))
#define P_VB ((bf16*)(R + R_V))
#define P_RB ((bf16*)(R + R_RB))
#define P_PTL ((bf16*)(R + R_PTL))
#define P_PTC ((bf16*)(R + R_PTC))
#define P_GB ((bf16*)(R + R_G))
#define P_YR ((bf16*)(R + R_YR))
#define P_YF ((bf16*)(R + R_YF))
#define P_MODP ((float*)(R + R_MODP))
#define P_NYQP ((float*)(R + R_PTL + 40 * MiB))
#define NORM_CNT(k) ((unsigned*)(ws + WS_CTL) + 16384 + (k) * 144 * 16)
#define P_XBUF ((float*)(ws + 244 * MiB))
#define XL_ ((__attribute__((address_space(3))) unsigned char*)(F.lds + MISC_OFF + 1024))
#define P_KVS ((float*)(ws + WS_XN + X_KV))
#define P_STS ((bf16*)(ws + WS_XN + X_ST))

    if (PH_ON) for (int rep_ = 0; rep_ < NREP(19); ++rep_) { PH_FRAME();
        p_adaln_partial(P, IN(1), IN(3), IN(4), P_MODP);
        __syncthreads();
        { WSrc S{IN(7), IN(8), IN(9), IN(11), IN(18), IN(15), IN(16), IN(17), IN(20), IN(22), IN(23), IN(24)}; p_convert(P, S, P_WB, 0x007u); }
    }
    PH_END();
    if (PH_ON) for (int rep_ = 0; rep_ < NREP(20); ++rep_) { PH_FRAME(); p_mod_finalize(P, IN(5), P_MODP, P_MOD); }
    PH_END();

    for (int l = 0; l < 2; ++l) {
        const bool l0 = (l == 0);
        const int nMall = l0 ? 144 : 128;
        if (PH_ON) { PH_FRAME();
            if (l0) p_norm<false>(P, IN(0), IN(2), IN(6) + l * DM, P_MODL, 0, 1, TALL, P_XN);
        }
        if (l0) PH_END();
        if (PH_ON) for (int rep_ = 0; rep_ < NREP(1); ++rep_) { PH_FRAME(); pg8::Gemm g{P_XN, P_WB + W_GU1, TALL, 2 * FFN, DM}; pg8::Order2 S; S.rect(144, 44, P.G, pbx); pg8::EpiSwiglu E{P_HB, FFN, rep_ + 1 < NREP(1)};
            pg8::gemm_phase<pg8::EpiSwiglu, pg8::Order2, true, true, true, true>(F.lds, g, S, E); }
        PH_END();
        if (PH_ON) for (int rep_ = 0; rep_ < NREP(2); ++rep_) { PH_FRAME(); pg8::Gemm g{P_HB, P_WB + W_D1, TALL, DM, FFN}; pg8::Order2 S; S.rect(144, 8, P.G, pbx); const bool dry = rep_ + 1 < NREP(2);
            (void)dry;
            if (l0) { pg8::EpiResidNorm<true, false> E{IN(0), IN(2), P_HLAT, P_HCTX, P_MODL, 2, 0.5f, IN(10) + l * DM, P_MODL, 3, 4, P_XN, nullptr, P_XBUF, NORM_CNT(l * 3 + 0), XL_}; pg8::gemm_phase<pg8::EpiResidNorm<true, false>, pg8::Order2, true, true, true, true>(F.lds, g, S, E); }
            else { pg8::EpiResidNorm<false, false> E{P_HLAT, P_HCTX, P_HLAT, P_HCTX, P_MODL, 2, 0.5f, IN(10) + l * DM, P_MODL, 3, 4, P_XN, nullptr, P_XBUF, NORM_CNT(l * 3 + 0), XL_}; pg8::gemm_phase<pg8::EpiResidNorm<false, false>, pg8::Order2, true, true, true, true>(F.lds, g, S, E); }
            if (pbx >= (1152 % P.G) && (1152 % P.G) > 0) {
                PH_FRAME_Q(Q, pbx - (1152 % P.G), P.G - (1152 % P.G));
                if (l0) { WSrc S2{IN(7), IN(8), IN(9), IN(11), IN(18), IN(15), IN(16), IN(17), IN(20), IN(22), IN(23), IN(24)}; p_convert(Q, S2, P_WB, 0xFD8u); __syncthreads();
                    p_fold(Q, IN(11), P_WB + W_FOLD); p_wbf_fold(Q, IN(15), P_WB + W_BF); p_consts(Q, (bf16*)(ws + WS_AMAT), (bf16*)(ws + WS_AMATC)); }
                else { const size_t a = (size_t)DM * FFN; WSrc S2{nullptr, nullptr, nullptr, nullptr, nullptr, nullptr, nullptr, nullptr, nullptr, IN(22) + a, IN(23) + a, IN(24) + a}; p_convert(Q, S2, P_WB, 0xE00u); } } }
        PH_END();
        if (PH_ON) { PH_FRAME();
            for (int rep_ = 0; rep_ < NREP(4); ++rep_) { pg8::Gemm g{P_XN, P_WB + W_CAT, TALL, NCAT, DM}; pg8::Order2 S;
              S.init(128, 38, 16, l0 ? 38 : 6, 128, l0 ? 38 : 2, l0 ? 0 : 4, l0 ? 0 : 6, P.G, pbx);
              pg8::EpiMix E{P_QB, P_KB, P_VB, P_RB, P_GB, IN(19) + (size_t)l * 6144};
              pg8::gemm_phase<pg8::EpiMix, pg8::Order2, true, true, true, true>(F.lds, g, S, E); }
            for (int rep_ = 0; rep_ < NREP(5); ++rep_) { pg8::Gemm g{P_WB + W_FOLD, P_XN, 512, TALL, DM}; pg8::Order2 S; S.rect(2, nMall, P.G, (pbx + (P.G >> 1)) % P.G);     pg8::EpiFold E{P_PTL, P_PTC};
              pg8::gemm_phase<pg8::EpiFold, pg8::Order2, true, true, true, true>(F.lds, g, S, E); }
        }
        PH_END();
        if (PH_ON) { PH_FRAME();
            p_qkprep(P, P_QB, P_KB, IN(12) + l * 128, IN(13) + l * 128, 0);
            for (int rep_ = 0; rep_ < NREP(7); ++rep_) for (int n = P.vcu; n < 576; n += P.G) { const int bh = n / 9, blk = n % 9, b = bh >> 2, h = bh & 3;
                const float lgf = -expf(IN(14)[l * 8 + h]) * 1.4426950408889634f, lgb = -expf(IN(14)[l * 8 + 4 + h]) * 1.4426950408889634f;
                const long rowbase = blk ? (long)b * SEQ + (blk - 1) * 256 : (long)TLAT + b * CTXL;
                att::ret_summary_unit(P_RB, P_KVS + (size_t)(bh * 9 + blk) * 2 * 16384, rowbase, h, lgf, lgb, (char*)lds); }
            __syncthreads();
            for (int rep_ = 0; rep_ < NREP(8); ++rep_) {
              { pg8::Gemm g{(bf16*)(ws + WS_AMAT), P_PTL, SEQ, 4096, SEQ}; pg8::Order2 S; S.rect(8, 16, P.G, pbx); pg8::EpiDft E{P_YF, 1.0f / 512.0f, SEQ, 0};
                pg8::gemm_phase<pg8::EpiDft, pg8::Order2, true, true>(F.lds, g, S, E); }
              { pg8::Gemm g{(bf16*)(ws + WS_AMAT) + (size_t)SEQ * SEQ, P_PTL + (size_t)16 * 256 * SEQ, SEQ, 4096, SEQ}; pg8::Order2 S; S.rect(8, 16, P.G, (pbx + (P.G >> 1)) % P.G); pg8::EpiDft E{P_YF, 1.0f / 512.0f, SEQ, 1};
                pg8::gemm_phase<pg8::EpiDft, pg8::Order2, true, true>(F.lds, g, S, E); } }
            if (l0) {
              { pg8::Gemm g{(bf16*)(ws + WS_AMATC), P_PTC, CTXL, 4096, CTXL}; pg8::Order2 S; S.rect(1, 16, P.G, (pbx + (P.G >> 2)) % P.G); pg8::EpiDft E{P_YF + (size_t)TLAT * 512, 0.005524271728019903f, CTXL, 0};
                pg8::gemm_phase<pg8::EpiDft, pg8::Order2, true, true>(F.lds, g, S, E); }
              { pg8::Gemm g{(bf16*)(ws + WS_AMATC) + (size_t)CTXL * CTXL, P_PTC + (size_t)16 * 256 * CTXL, CTXL, 4096, CTXL}; pg8::Order2 S; S.rect(1, 16, P.G, (pbx + 3 * (P.G >> 2)) % P.G); pg8::EpiDft E{P_YF + (size_t)TLAT * 512, 0.005524271728019903f, CTXL, 1};
                pg8::gemm_phase<pg8::EpiDft, pg8::Order2, true, true>(F.lds, g, S, E); } }
        }
        PH_END();
        if (PH_ON) { PH_FRAME();
            for (int rep_ = 0; rep_ < NREP(9); ++rep_) p_ret_scan(P, P_KVS, P_STS, IN(14) + l * 8);
            __syncthreads();
#pragma unroll 1
            for (int ks = 0; ks < 8; ++ks) { pg8::Gemm g{(bf16*)(ws + WS_AMAT) + ks * 256, P_PTL + (size_t)2 * 16 * 256 * SEQ + ks * 256, SEQ, 256, 256, SEQ, SEQ}; pg8::Order2 S; S.rect(8, 1, P.G, (pbx + P.G - 8 * ks) % P.G);
              pg8::EpiNyqP E{P_NYQP + (size_t)ks * SEQ * 64};
              pg8::gemm_phase<pg8::EpiNyqP, pg8::Order2, true, true>(F.lds, g, S, E); }
            if (l0) { pg8::Gemm g{(bf16*)(ws + WS_AMATC), P_PTC + (size_t)2 * 16 * 256 * CTXL, CTXL, 256, CTXL}; pg8::Order2 S; S.rect(1, 1, P.G, (pbx + (P.G >> 2)) % P.G); pg8::EpiNyq E{P_YF + (size_t)TLAT * 512, 0.005524271728019903f, CTXL};
              pg8::gemm_phase<pg8::EpiNyq, pg8::Order2, true, true>(F.lds, g, S, E); }
        }
        PH_END();
        if (PH_ON) { PH_FRAME();
            for (int i = P.vcu * NTHR + P.tid; i < SEQ * 64; i += P.G * NTHR) { const int t = i >> 6, c = i & 63; float sum = 0.f;
#pragma unroll
                for (int ks = 0; ks < 8; ++ks) sum += P_NYQP[(size_t)ks * SEQ * 64 + i];
                P_YF[((size_t)(c >> 2) * SEQ + t) * 512 + (c & 3) * 128 + 64] = (bf16)(pk2(sum * (1.0f / 512.0f), 0.f) & 0xffffu); }
            const int nat = l0 ? 1152 : 1024, nrt = l0 ? 576 : 512;
            const bool rfirst = (P.vcu & 1) != 0;
#pragma unroll 1
            for (int pass = 0; pass < 2; ++pass) {
            if ((pass == 0) != rfirst) {
            for (int rep_ = 0; rep_ < NREP(10); ++rep_) { const bool dry = rep_ + 1 < NREP(10);
            for (int n = P.vcu; n < nat; n += P.G) {
                if (n < 1024) { const int grp = n >> 5, loc = n & 31, b = grp >> 1, kvh = grp & 1, head = kvh * 4 + (loc >> 3), qb = loc & 7;
                    bf16* qp = P_QB + ((size_t)b * SEQ + qb * 256) * 1024 + head * 128;
                    att::attn_dense_body(qp, P_KB + (size_t)b * KVROWS * 256 + kvh * 128, P_VB + (size_t)b * KVROWS * 256 + kvh * 128, dry ? P_PTL : qp, KVROWS, (char*)lds, IN(12) + l * 128, qb * 256); }
                else { const int m = n - 1024, b = m >> 3, head = m & 7, kvh = head >> 2;
                    bf16* qp = P_QB + ((size_t)TLAT + b * CTXL) * 1024 + head * 128;
                    att::attn_dense_body(qp, P_KB + (size_t)b * KVROWS * 256 + kvh * 128, P_VB + (size_t)b * KVROWS * 256 + kvh * 128, dry ? P_PTL : qp, CTXL, (char*)lds, IN(12) + l * 128, -1); }
            } } } else {
            for (int rep_ = 0; rep_ < NREP(11); ++rep_) for (int n = (P.vcu + (P.G >> 1)) % P.G; n < nrt; n += P.G) {
                int bh, blk; if (n < 512) { bh = n >> 3; blk = (n & 7) + 1; } else { bh = n - 512; blk = 0; }
                const int b = bh >> 2, h = bh & 3;
                const float lgf = -expf(IN(14)[l * 8 + h]) * 1.4426950408889634f, lgb = -expf(IN(14)[l * 8 + 4 + h]) * 1.4426950408889634f;
                const long rowbase = blk ? (long)b * SEQ + (blk - 1) * 256 : (long)TLAT + b * CTXL;
                const bf16* sf = blk ? P_STS + ((size_t)(bh * 8 + blk - 1) * 2) * 16384 : nullptr;
                att::ret_output_unit(P_RB, sf, blk ? sf + 16384 : nullptr, P_YR, rowbase, h, lgf, lgb, (char*)lds);
                __syncthreads(); } } }
        }
        PH_END();
        if (PH_ON) { PH_FRAME();
            for (int rep_ = 0; rep_ < NREP(12); ++rep_) { pg8::Gemm g{P_YF, P_WB + W_BF, nMall * 256, DM, 512}; pg8::Order2 S; S.rect(nMall, 8, P.G, pbx); pg8::EpiMerge<true> E{P_XN, P_GB, 0};
                pg8::gemm_phase<pg8::EpiMerge<true>, pg8::Order2, true, true, false, true>(F.lds, g, S, E); }
            asm volatile("s_waitcnt vmcnt(0)" ::: "memory");
            { pg8::Gemm g{P_QB, P_WB + W_BA, nMall * 256, DM, 1024}; pg8::Order2 S; S.rect(nMall, 8, P.G, pbx); pg8::EpiMerge<false> E{P_XN, P_GB, 2048};
                pg8::gemm_phase<pg8::EpiMerge<false>, pg8::Order2, true, true, false, true>(F.lds, g, S, E); }
            asm volatile("s_waitcnt vmcnt(0)" ::: "memory");
            { pg8::Gemm g{P_YR, P_WB + W_BR, nMall * 256, DM, 512}; pg8::Order2 S; S.rect(nMall, 8, P.G, pbx); pg8::EpiMerge<false> E{P_XN, P_GB, 4096};
                pg8::gemm_phase<pg8::EpiMerge<false>, pg8::Order2, true, true, false, true>(F.lds, g, S, E); }
        }
        PH_END();
        if (PH_ON) for (int rep_ = 0; rep_ < NREP(15); ++rep_) { PH_FRAME(); pg8::Gemm g{P_XN, P_WB + W_OUT, nMall * 256, DM, DM}; pg8::Order2 S; S.rect(nMall, 8, P.G, pbx); const bool dry = rep_ + 1 < NREP(15);
            (void)dry;
            pg8::EpiResidNorm<false, false> E{P_HLAT, P_HCTX, l0 ? P_HLAT : P_HFIN, P_HCTX, P_MODL, 5, 1.0f, IN(21) + l * DM, P_MODL, 6, 7, P_XN, nullptr, P_XBUF, NORM_CNT(l * 3 + 1), XL_};
            pg8::gemm_phase<pg8::EpiResidNorm<false, false>, pg8::Order2, true, true, false, true>(F.lds, g, S, E); }
        PH_END();
        if (PH_ON) for (int rep_ = 0; rep_ < NREP(17); ++rep_) { PH_FRAME(); pg8::Gemm g{P_XN, P_WB + W_GU2, nMall * 256, 2 * FFN, DM}; pg8::Order2 S; S.rect(nMall, 44, P.G, pbx); pg8::EpiSwiglu E{P_HB, FFN, rep_ + 1 < NREP(17)};
            pg8::gemm_phase<pg8::EpiSwiglu, pg8::Order2, true, true, true, true>(F.lds, g, S, E); }
        PH_END();
        if (PH_ON) for (int rep_ = 0; rep_ < NREP(18); ++rep_) { PH_FRAME(); pg8::Gemm g{P_HB, P_WB + W_D2, nMall * 256, DM, FFN}; pg8::Order2 S; S.rect(nMall, 8, P.G, pbx); const bool dry = rep_ + 1 < NREP(18);
            (void)dry;
            if (l0) { pg8::EpiResidNorm<false, false> E{P_HLAT, P_HCTX, P_HLAT, P_HCTX, P_MODL, 8, 0.5f, IN(6) + (l + 1) * DM, P_MOD + (size_t)(l + 1) * 17 * NMODC, 0, 1, P_XN, nullptr, P_XBUF, NORM_CNT(l * 3 + 2), XL_};
                pg8::gemm_phase<pg8::EpiResidNorm<false, false>, pg8::Order2, true, true, true, true>(F.lds, g, S, E); }
            else { pg8::EpiResidNorm<false, true> E{P_HFIN, P_HCTX, nullptr, nullptr, P_MODL, 8, 0.5f, IN(25), nullptr, 0, 0, nullptr, args.out + z_, P_XBUF, NORM_CNT(l * 3 + 2), XL_};
                pg8::gemm_phase<pg8::EpiResidNorm<false, true>, pg8::Order2, true, true, true, true>(F.lds, g, S, E); }
            if (l0 && pbx >= (1152 % P.G) && (1152 % P.G) > 0) {
                PH_FRAME_Q(Q, pbx - (1152 % P.G), P.G - (1152 % P.G));
                const size_t a = (size_t)DM * FFN, b = (size_t)DM * 4096, c = (size_t)DM * 6144;
                const size_t d5 = (size_t)512 * DM, d10 = (size_t)1024 * DM, e = (size_t)DM * DM;
                WSrc S2{IN(7) + a, IN(8) + a, IN(9) + a, IN(11) + b, IN(18) + c, IN(15) + d5, IN(16) + d10, IN(17) + d5, IN(20) + e, nullptr, nullptr, nullptr}; p_convert(Q, S2, P_WB, 0x1DFu); __syncthreads();
                p_fold(Q, IN(11) + b, P_WB + W_FOLD); p_wbf_fold(Q, IN(15) + d5, P_WB + W_BF); } }
        if (l0) PH_END();
    }
    (void)ph; (void)lo; (void)hi;
}

extern "C" void kernel_launch(void* const* d_in, const int* in_sizes, int n_in, void* d_out, int out_size, void* d_ws, size_t ws_size, hipStream_t stream) {
    static int grid = 0;
    if (grid == 0) {
        if (n_in != 26 || in_sizes[0] != TLAT * DM || out_size != TLAT * DM || ws_size < WS_END) { fprintf(stderr, "kernel_launch: shape/workspace mismatch (n_in %d, in0 %d, out %d, ws %zu < %zu); nothing launched\n", n_in, n_in > 0 ? in_sizes[0] : -1, out_size, ws_size, (size_t)WS_END); grid = -1; return; }
        int dev = 0, cus = 0, per_cu = 0;
        if (hipGetDevice(&dev) != hipSuccess || hipDeviceGetAttribute(&cus, hipDeviceAttributeMultiprocessorCount, dev) != hipSuccess) { grid = -1; return; }
        if (hipFuncSetAttribute((const void*)mk_fwd, hipFuncAttributeMaxDynamicSharedMemorySize, LDS_BYTES) != hipSuccess) { fprintf(stderr, "kernel_launch: hipFuncSetAttribute failed\n"); grid = -1; return; }
        if (hipOccupancyMaxActiveBlocksPerMultiprocessor(&per_cu, (const void*)mk_fwd, NTHR, LDS_BYTES) != hipSuccess || per_cu < 1) fprintf(stderr, "kernel_launch: note: occupancy query reports %d workgroups per CU\n", per_cu);
        (void)hipGetLastError();
        grid = cus;
    }
    if (grid < 0) return;
    if (hipMemsetAsync((char*)d_ws + WS_CTL, 0, CTL_ZERO_BYTES, stream) != hipSuccess) { fprintf(stderr, "kernel_launch: memset failed\n"); return; }
    Args a{};
    for (int i = 0; i < 26; ++i) a.in[i] = (const float*)d_in[i];
    a.out = (float*)d_out; a.ws = (unsigned char*)d_ws;
#if MK_PER_PHASE
    for (int p = 0; p < N_PHASES; ++p) { a.ph_lo = p; a.ph_hi = p + 1; hipLaunchKernelGGL(mk_fwd, dim3(grid), dim3(NTHR), LDS_BYTES, stream, a); }
#else
    a.ph_lo = 0; a.ph_hi = N_PHASES; hipLaunchKernelGGL(mk_fwd, dim3(grid), dim3(NTHR), LDS_BYTES, stream, a);
#endif
    const hipError_t le = hipPeekAtLastError();
    if (le != hipSuccess) fprintf(stderr, "kernel_launch: launch failed: %s\n", hipGetErrorName(le));
}
```
